# Optimizing an MI355X kernel written in HIP

```python
import math
import jax, jax.numpy as jnp
from jax import lax
import numpy as np

D_MODEL = 1024
BATCH = 4
SEQ = 4096
DEPTH = 2

GRID_W = 64
CTX_LEN = 256
N_MIXERS = 2
S5_H = 16
S5_G = D_MODEL // S5_H
S5_P = 64
DT_MIN, DT_MAX = 1e-3, 1e-1
POOL_WINDOWS = (2, 4, 8, 16)
POOL_G = len(POOL_WINDOWS)
POOL_DG = D_MODEL // POOL_G
N_EXPERTS = 16
N_EXPERT_GROUPS = 4
EXPERTS_PER_GROUP = N_EXPERTS // N_EXPERT_GROUPS
TOP_K = 2
D_FF = 1024
N_S5_LAYERS = (DEPTH + 1) // 2
N_POOL_LAYERS = DEPTH // 2
DN_ALPHA = (2 * DEPTH) ** 0.25
DN_BETA = (8 * DEPTH) ** -0.25
LN_EPS = 1e-5

kernel_name = 'hybrid_s5_pool_moe_dit'


def _layer_norm(x, g, b):
    xf = x.astype(jnp.float32)
    mu = jnp.mean(xf, axis=-1, keepdims=True)
    var = jnp.mean(jnp.square(xf - mu), axis=-1, keepdims=True)
    y = (xf - mu) * lax.rsqrt(var + LN_EPS)
    return (y * g.astype(jnp.float32) + b.astype(jnp.float32)).astype(x.dtype)


def _modulation(cond, w, b):
    m = jnp.dot(jax.nn.silu(cond), w) + b
    return jnp.split(m, 6, axis=-1)


def _s5_discretize(lam_re, lam_im, log_dt, b_re, b_im):
    f32 = jnp.float32
    lr = lam_re.astype(f32)
    li = lam_im.astype(f32)
    dt = jnp.exp(log_dt.astype(f32))[:, None]
    mag = jnp.exp(lr * dt)
    ar = mag * jnp.cos(li * dt)
    ai = mag * jnp.sin(li * dt)
    den = lr * lr + li * li
    nr = ar - 1.0
    fr = (nr * lr + ai * li) / den
    fi = (ai * lr - nr * li) / den
    br_, bi_ = b_re.astype(f32), b_im.astype(f32)
    bbr = fr[..., None] * br_ - fi[..., None] * bi_
    bbi = fr[..., None] * bi_ + fi[..., None] * br_
    return ar, ai, bbr, bbi


def _complex_scan_combine(e1, e2):
    a1r, a1i, b1r, b1i = e1
    a2r, a2i, b2r, b2i = e2
    return (a2r * a1r - a2i * a1i,
            a2r * a1i + a2i * a1r,
            a2r * b1r - a2i * b1i + b2r,
            a2r * b1i + a2i * b1r + b2i)


def _s5_scan(u, ar, ai, bbr, bbi, h0, reverse):
    n = u.shape[1]
    bur = jnp.einsum('blgh,gph->blgp', u, bbr)
    bui = jnp.einsum('blgh,gph->blgp', u, bbi)
    a_shape = (1, n) + ar.shape
    elems = (jnp.broadcast_to(ar, a_shape), jnp.broadcast_to(ai, a_shape), bur, bui)
    acr, aci, xr, xi = lax.associative_scan(_complex_scan_combine, elems, reverse=reverse, axis=1)
    if h0 is not None:
        h0r = h0[0][:, None]
        h0i = h0[1][:, None]
        xr = xr + acr * h0r - aci * h0i
        xi = xi + acr * h0i + aci * h0r
    return xr, xi


def _s5_readout(xr, xi, c_re, c_im):
    return jnp.einsum('blgp,ghp->blgh', xr, c_re) - jnp.einsum('blgp,ghp->blgh', xi, c_im)


def _glu(y, w_val, w_gate, dtype):
    y = jax.nn.gelu(y).astype(dtype)
    return jnp.dot(y, w_val) * jax.nn.sigmoid(jnp.dot(y, w_gate))


def _s5_mixer(h_lat, h_ctx, lam_re, lam_im, log_dt, b_re, b_im, c_re, c_im, d_skip, w_val, w_gate, ctx_out):
    f32 = jnp.float32
    bsz, n_lat, _ = h_lat.shape
    n_ctx = h_ctx.shape[1]
    u_lat = h_lat.astype(f32).reshape(bsz, n_lat, S5_G, S5_H)
    u_ctx = h_ctx.astype(f32).reshape(h_ctx.shape[0], n_ctx, S5_G, S5_H)
    d = d_skip.astype(f32).reshape(S5_G, S5_H)
    y_lat = d * u_lat
    y_ctx = d * u_ctx if ctx_out else None
    for direction, reverse in ((0, False), (1, True)):
        ar, ai, bbr, bbi = _s5_discretize(lam_re[direction], lam_im[direction], log_dt[direction],
                                          b_re[direction], b_im[direction])
        cr = c_re[direction].astype(f32)
        ci = c_im[direction].astype(f32)
        xr_c, xi_c = _s5_scan(u_ctx, ar, ai, bbr, bbi, None, reverse)
        end = 0 if reverse else n_ctx - 1
        xr, xi = _s5_scan(u_lat, ar, ai, bbr, bbi, (xr_c[:, end], xi_c[:, end]), reverse)
        y_lat = y_lat + _s5_readout(xr, xi, cr, ci)
        if ctx_out:
            y_ctx = y_ctx + _s5_readout(xr_c, xi_c, cr, ci)
    out_lat = _glu(y_lat.reshape(bsz, n_lat, D_MODEL), w_val, w_gate, h_lat.dtype)
    out_ctx = _glu(y_ctx.reshape(bsz, n_ctx, D_MODEL), w_val, w_gate, h_ctx.dtype) if ctx_out else None
    return out_lat, out_ctx


def _box_sum(x, k, axis):
    n = x.shape[axis]
    cs = jnp.cumsum(x, axis=axis)
    cs = jnp.concatenate([jnp.zeros_like(lax.slice_in_dim(cs, 0, 1, axis=axis)), cs], axis=axis)
    t = jnp.arange(n)
    lo = jnp.clip(t - k // 2, 0, n)
    hi = jnp.clip(t + k - k // 2, 0, n)
    s = jnp.take(cs, hi, axis=axis) - jnp.take(cs, lo, axis=axis)
    shape = [1] * x.ndim
    shape[axis] = n
    return s, (hi - lo).astype(jnp.float32).reshape(shape)


def _pool_mixer(h, w_grp, scale, rows):
    bsz, n, d = h.shape
    hf = h.astype(jnp.float32)
    view = hf.reshape(bsz, rows, GRID_W, d) if rows is not None else hf
    parts = []
    for g, k in enumerate(POOL_WINDOWS):
        xg = view[..., g * POOL_DG:(g + 1) * POOL_DG]
        if rows is not None:
            s, cnt_c = _box_sum(xg, k, 2)
            s, cnt_r = _box_sum(s, k, 1)
            mean = s / (cnt_c * cnt_r)
        else:
            s, cnt = _box_sum(xg, k, 1)
            mean = s / cnt
        parts.append((mean - xg).reshape(bsz, n, POOL_DG))
    pooled = jnp.stack(parts, axis=2).astype(h.dtype)
    out = jnp.einsum('bngc,gcd->bngd', pooled, w_grp).reshape(bsz, n, d)
    return out * scale


def _moe(h, router_w, router_b, w_gate, w_up, w_down):
    f32 = jnp.float32
    shp = h.shape
    t = h.reshape(-1, shp[-1])
    logits = jnp.dot(t, router_w).astype(f32) + router_b.astype(f32)
    scores = jax.nn.softmax(logits, axis=-1)
    sg = scores.reshape(-1, N_EXPERT_GROUPS, EXPERTS_PER_GROUP)
    group_score = jnp.sum(lax.top_k(sg, TOP_K)[0], axis=-1)
    best = jnp.argmax(group_score, axis=-1)
    in_group = jnp.take_along_axis(sg, best[:, None, None], axis=1)[:, 0]
    top_w, top_i = lax.top_k(in_group, TOP_K)
    top_w = top_w / jnp.sum(top_w, axis=-1, keepdims=True)
    expert_idx = best[:, None] * EXPERTS_PER_GROUP + top_i
    combine = jnp.sum(jax.nn.one_hot(expert_idx, N_EXPERTS, dtype=f32) * top_w[..., None], axis=1)
    out = jnp.zeros(t.shape, f32)
    for e in range(N_EXPERTS):
        a = jax.nn.silu(jnp.dot(t, w_gate[e])) * jnp.dot(t, w_up[e])
        out = out + combine[:, e:e + 1] * jnp.dot(a, w_down[e]).astype(f32)
    return out.astype(h.dtype).reshape(shp)


def setup_inputs(seed: int = 0) -> dict:
    key = jax.random.key(seed)
    ks = jax.random.split(key, 26)
    f32 = jnp.float32

    def nrm(k, shape, s):
        return jax.random.normal(k, shape, f32) * s

    D, G, P, H, E, F = D_MODEL, S5_G, S5_P, S5_H, N_EXPERTS, D_FF
    n_idx = jnp.arange(P, dtype=f32)
    return {
        'x': nrm(ks[0], (BATCH, SEQ, D), 1.0),
        'c': nrm(ks[1], (BATCH, D), 1.0),
        'ctx': nrm(ks[2], (BATCH, CTX_LEN, D), 1.0),
        'c_ctx': nrm(ks[3], (D,), 1.0),
        'mod_w': nrm(ks[4], (DEPTH, D, 6 * D), 0.5 * D ** -0.5),
        'mod_b': nrm(ks[5], (DEPTH, 6 * D), 0.02),
        'ln_g': 1.0 + nrm(ks[6], (DEPTH, 2, D), 0.02),
        'ln_b': nrm(ks[7], (DEPTH, 2, D), 0.02),
        's5_lam_re': -0.5 + nrm(ks[8], (N_S5_LAYERS, 2, G, P), 0.01),
        's5_lam_im': math.pi * n_idx + nrm(ks[9], (N_S5_LAYERS, 2, G, P), 0.01),
        's5_log_dt': jax.random.uniform(ks[10], (N_S5_LAYERS, 2, G), f32, math.log(DT_MIN), math.log(DT_MAX)),
        's5_b_re': nrm(ks[11], (N_S5_LAYERS, 2, G, P, H), (2 * H) ** -0.5),
        's5_b_im': nrm(ks[12], (N_S5_LAYERS, 2, G, P, H), (2 * H) ** -0.5),
        's5_c_re': nrm(ks[13], (N_S5_LAYERS, 2, G, H, P), P ** -0.5),
        's5_c_im': nrm(ks[14], (N_S5_LAYERS, 2, G, H, P), P ** -0.5),
        's5_d': nrm(ks[15], (N_S5_LAYERS, D), 1.0),
        's5_w_val': nrm(ks[16], (N_S5_LAYERS, D, D), DN_BETA * D ** -0.5),
        's5_w_gate': nrm(ks[17], (N_S5_LAYERS, D, D), D ** -0.5),
        'pool_w': nrm(ks[18], (N_POOL_LAYERS, POOL_G, POOL_DG, POOL_DG), DN_BETA * POOL_DG ** -0.5),
        'pool_scale': 1.0 + nrm(ks[19], (N_POOL_LAYERS, D), 0.02),
        'router_w': nrm(ks[20], (D, E), D ** -0.5),
        'router_b': nrm(ks[21], (E,), 0.01),
        'moe_w_gate': nrm(ks[22], (DEPTH, E, D, F), D ** -0.5),
        'moe_w_up': nrm(ks[23], (DEPTH, E, D, F), D ** -0.5),
        'moe_w_down': nrm(ks[24], (DEPTH, E, F, D), DN_BETA * F ** -0.5),
    }


def reference(x, c, ctx, c_ctx, mod_w, mod_b, ln_g, ln_b, s5_lam_re, s5_lam_im, s5_log_dt, s5_b_re, s5_b_im,
              s5_c_re, s5_c_im, s5_d, s5_w_val, s5_w_gate, pool_w, pool_scale, router_w, router_b,
              moe_w_gate, moe_w_up, moe_w_down):
    rows = x.shape[1] // GRID_W
    cond_lat = c[:, None, :]
    cond_ctx = c_ctx[None, None, :]
    is_s5 = [i % N_MIXERS == 0 for i in range(DEPTH)]
    for i in range(DEPTH):
        j = i // N_MIXERS
        ctx_active = any(is_s5[i:])
        ctx_advance = any(is_s5[i + 1:])
        sh1, sc1, g1, sh2, sc2, g2 = _modulation(cond_lat, mod_w[i], mod_b[i])
        h = x * (1.0 + sc1) + sh1
        if ctx_active:
            csh1, csc1, cg1, csh2, csc2, cg2 = _modulation(cond_ctx, mod_w[i], mod_b[i])
            hc = ctx * (1.0 + csc1) + csh1
        if is_s5[i]:
            m, mc = _s5_mixer(h, hc, s5_lam_re[j], s5_lam_im[j], s5_log_dt[j], s5_b_re[j], s5_b_im[j],
                              s5_c_re[j], s5_c_im[j], s5_d[j], s5_w_val[j], s5_w_gate[j], ctx_advance)
        else:
            m = _pool_mixer(h, pool_w[j], pool_scale[j], rows)
            mc = _pool_mixer(hc, pool_w[j], pool_scale[j], None) if ctx_advance else None
        x = _layer_norm(DN_ALPHA * x + g1 * m, ln_g[i, 0], ln_b[i, 0])
        h = x * (1.0 + sc2) + sh2
        x = _layer_norm(DN_ALPHA * x + g2 * _moe(h, router_w, router_b, moe_w_gate[i], moe_w_up[i], moe_w_down[i]),
                        ln_g[i, 1], ln_b[i, 1])
        if ctx_advance:
            ctx = _layer_norm(DN_ALPHA * ctx + cg1 * mc, ln_g[i, 0], ln_b[i, 0])
            hc = ctx * (1.0 + csc2) + csh2
            ctx = _layer_norm(DN_ALPHA * ctx + cg2 * _moe(hc, router_w, router_b, moe_w_gate[i], moe_w_up[i],
                                                          moe_w_down[i]), ln_g[i, 1], ln_b[i, 1])
    return x
```

```cpp
#include <hip/hip_runtime.h>
#include <cstdio>
#include <cstdint>
#include <cmath>

constexpr int D = 1024, BATCH = 4, SEQ = 4096, NTOK = BATCH * SEQ, CTXL = 256;
constexpr int S5G = 64, S5H = 16, S5P = 64;
constexpr int NE = 16, NGRP = 4, EPG = 4, FF = 1024;
constexpr int MAXSLOT = 2 * NTOK + NE * 256;
constexpr int MAXTILE = MAXSLOT / 256;
constexpr float DN_ALPHA = 1.4142135623730951f;
constexpr float LN_EPS = 1e-5f;

__device__ __forceinline__ float silu_f(float v) { return v / (1.f + expf(-v)); }
__device__ __forceinline__ float sigmoid_f(float v) { return 1.f / (1.f + expf(-v)); }
__device__ __forceinline__ float gelu_tanh_f(float v) { const float u = 0.7978845608028654f * (v + 0.044715f * v * v * v); return 0.5f * v * (1.f + tanhf(u)); }

__global__ void k_modvec(const float* __restrict__ c, const float* __restrict__ c_ctx, const float* __restrict__ mod_w, const float* __restrict__ mod_b, float* __restrict__ modv) {
    const int n = blockIdx.x * blockDim.x + threadIdx.x;
    const int l = blockIdx.y;
    __shared__ float s[5][D];
    for (int i = threadIdx.x; i < 5 * D; i += blockDim.x) { const int r = i / D, k = i % D; const float v = r < 4 ? c[r * D + k] : c_ctx[k]; s[r][k] = silu_f(v); }
    __syncthreads();
    float acc[5] = {0.f, 0.f, 0.f, 0.f, 0.f};
    const float* w = mod_w + (size_t)l * D * 6 * D + n;
    for (int k = 0; k < D; ++k) { const float wv = w[(size_t)k * 6 * D];
#pragma unroll
        for (int r = 0; r < 5; ++r) acc[r] += s[r][k] * wv; }
    const float b = mod_b[l * 6 * D + n];
    for (int r = 0; r < 5; ++r) modv[((size_t)l * 5 + r) * 6 * D + n] = acc[r] + b;
}

__global__ void k_s5_disc(const float* lam_re, const float* lam_im, const float* log_dt, const float* b_re, const float* b_im, float* ar, float* ai, float* bbr, float* bbi) {
    const int idx = blockIdx.x * blockDim.x + threadIdx.x;
    if (idx >= 2 * S5G * S5P) return;
    const int g = (idx / S5P) % S5G, dir = idx / (S5P * S5G);
    const float lr = lam_re[idx], li = lam_im[idx], dt = expf(log_dt[dir * S5G + g]);
    const float mag = expf(lr * dt), a_r = mag * cosf(li * dt), a_i = mag * sinf(li * dt);
    const float den = lr * lr + li * li, nr = a_r - 1.f;
    const float fr = (nr * lr + a_i * li) / den, fi = (a_i * lr - nr * li) / den;
    ar[idx] = a_r; ai[idx] = a_i;
    for (int h = 0; h < S5H; ++h) { const float br = b_re[(size_t)idx * S5H + h], bi = b_im[(size_t)idx * S5H + h];
        bbr[(size_t)idx * S5H + h] = fr * br - fi * bi; bbi[(size_t)idx * S5H + h] = fr * bi + fi * br; }
}

__global__ void __launch_bounds__(64) k_s5_naive(const float* __restrict__ x, const float* __restrict__ ctx, const float* __restrict__ modv0,
                           const float* ar, const float* ai, const float* bbr, const float* bbi, const float* c_re, const float* c_im, float* __restrict__ ydir) {
    const int g = blockIdx.x, b = blockIdx.y, dir = blockIdx.z, p = threadIdx.x;
    const int sidx = (dir * S5G + g) * S5P + p;
    const float a_r = ar[sidx], a_i = ai[sidx];
    float br[S5H], bi[S5H];
#pragma unroll
    for (int h = 0; h < S5H; ++h) { br[h] = bbr[(size_t)sidx * S5H + h]; bi[h] = bbi[(size_t)sidx * S5H + h]; }
    float cr[S5H], ci[S5H];
#pragma unroll
    for (int h = 0; h < S5H; ++h) { cr[h] = c_re[((size_t)(dir * S5G + g) * S5H + h) * S5P + p]; ci[h] = c_im[((size_t)(dir * S5G + g) * S5H + h) * S5P + p]; }
    const float* ml = modv0 + (size_t)b * 6 * D; const float* mc = modv0 + (size_t)4 * 6 * D;
    float xr = 0.f, xi = 0.f;
    __shared__ float ysh[S5H];
    for (int s = 0; s < CTXL; ++s) {
        const int t = dir == 0 ? s : CTXL - 1 - s;
        float bur = 0.f, bui = 0.f;
#pragma unroll
        for (int h = 0; h < S5H; ++h) { const int ch = g * S5H + h; const float u = ctx[((size_t)b * CTXL + t) * D + ch] * (1.f + mc[D + ch]) + mc[ch]; bur += br[h] * u; bui += bi[h] * u; }
        const float nr = a_r * xr - a_i * xi + bur, ni = a_r * xi + a_i * xr + bui; xr = nr; xi = ni;
    }
    for (int s = 0; s < SEQ; ++s) {
        const int t = dir == 0 ? s : SEQ - 1 - s;
        float bur = 0.f, bui = 0.f;
#pragma unroll
        for (int h = 0; h < S5H; ++h) { const int ch = g * S5H + h; const float u = x[((size_t)b * SEQ + t) * D + ch] * (1.f + ml[D + ch]) + ml[ch]; bur += br[h] * u; bui += bi[h] * u; }
        const float nr = a_r * xr - a_i * xi + bur, ni = a_r * xi + a_i * xr + bui; xr = nr; xi = ni;
#pragma unroll
        for (int h = 0; h < S5H; ++h) { float v = cr[h] * xr - ci[h] * xi;
#pragma unroll
            for (int o = 32; o >= 1; o >>= 1) v += __shfl_xor(v, o);
            if (p == h) ysh[h] = v; }
        __syncthreads();
        if (p < S5H) ydir[((size_t)dir * NTOK + (size_t)b * SEQ + t) * D + g * S5H + p] = ysh[p];
        __syncthreads();
    }
}

__global__ void k_glu_in(const float* __restrict__ x, const float* __restrict__ modv0, const float* __restrict__ s5d, const float* __restrict__ ydir, float* __restrict__ yact) {
    const size_t i = (size_t)blockIdx.x * blockDim.x + threadIdx.x; if (i >= (size_t)NTOK * D) return;
    const int ch = (int)(i % D); const int tok = (int)(i / D), b = tok / SEQ;
    const float* ml = modv0 + (size_t)b * 6 * D;
    const float h = x[i] * (1.f + ml[D + ch]) + ml[ch];
    const float y = s5d[ch] * h + ydir[i] + ydir[(size_t)NTOK * D + i];
    yact[i] = gelu_tanh_f(y);
}

__global__ void __launch_bounds__(256) k_gemm_naive(const float* __restrict__ A, int lda, const int* __restrict__ rowmap, const float* __restrict__ B, int ldb, size_t bstride, const int* __restrict__ tile_b,
                                                    float* __restrict__ C, int ldc, int M, int N, int K, const int* __restrict__ mrows, int a_col_off, int c_col_off) {
    const int m0 = blockIdx.y * 64, n0 = blockIdx.x * 64;
    const int Mr = mrows ? *mrows : M; if (m0 >= Mr) return;
    const float* Bm = B + (tile_b ? (size_t)tile_b[m0 / 256] * bstride : 0);
    __shared__ float As[16][65], Bs[16][65];
    const int tx = threadIdx.x % 16, ty = threadIdx.x / 16;
    float acc[4][4] = {};
    for (int k0 = 0; k0 < K; k0 += 16) {
        for (int i = threadIdx.x; i < 64 * 16; i += 256) { const int r = i / 16, kk = i % 16; int row = m0 + r; float v = 0.f;
            if (row < Mr) { if (rowmap) row = rowmap[row]; if (row >= 0) v = A[(size_t)row * lda + a_col_off + k0 + kk]; } As[kk][r] = v; }
        for (int i = threadIdx.x; i < 64 * 16; i += 256) { const int kk = i / 64, c = i % 64; Bs[kk][c] = Bm[(size_t)(k0 + kk) * ldb + n0 + c]; }
        __syncthreads();
#pragma unroll
        for (int kk = 0; kk < 16; ++kk) { float a[4], bb[4];
#pragma unroll
            for (int i = 0; i < 4; ++i) { a[i] = As[kk][ty * 4 + i]; bb[i] = Bs[kk][tx * 4 + i]; }
#pragma unroll
            for (int i = 0; i < 4; ++i)
#pragma unroll
                for (int j = 0; j < 4; ++j) acc[i][j] += a[i] * bb[j]; }
        __syncthreads();
    }
    for (int i = 0; i < 4; ++i) { const int row = m0 + ty * 4 + i; if (row >= Mr) continue;
        for (int j = 0; j < 4; ++j) C[(size_t)row * ldc + c_col_off + n0 + tx * 4 + j] = acc[i][j]; }
}

__global__ void __launch_bounds__(256) k_res_ln(const float* __restrict__ xin, const float* __restrict__ V, const float* __restrict__ Gt, const float* __restrict__ pscale, int mode,
                                                const float* __restrict__ modv, const float* __restrict__ lng, const float* __restrict__ lnb, float* __restrict__ xout, float* __restrict__ h2) {
    const int row = blockIdx.x * 4 + (threadIdx.x >> 6), lane = threadIdx.x & 63; if (row >= NTOK) return;
    const int b = row / SEQ; const float* ml = modv + (size_t)b * 6 * D;
    float v[16]; float s = 0.f;
#pragma unroll
    for (int j = 0; j < 16; ++j) { const int ch = lane + 64 * j; const size_t i = (size_t)row * D + ch;
        const float m = mode == 0 ? V[i] * sigmoid_f(Gt[i]) : V[i] * pscale[ch];
        v[j] = DN_ALPHA * xin[i] + ml[2 * D + ch] * m; s += v[j]; }
#pragma unroll
    for (int o = 32; o >= 1; o >>= 1) s += __shfl_xor(s, o);
    const float mean = s * (1.f / D); float q = 0.f;
#pragma unroll
    for (int j = 0; j < 16; ++j) { const float d = v[j] - mean; q += d * d; }
#pragma unroll
    for (int o = 32; o >= 1; o >>= 1) q += __shfl_xor(q, o);
    const float rstd = 1.f / sqrtf(q * (1.f / D) + LN_EPS);
#pragma unroll
    for (int j = 0; j < 16; ++j) { const int ch = lane + 64 * j; const size_t i = (size_t)row * D + ch;
        const float o = (v[j] - mean) * rstd * lng[ch] + lnb[ch]; xout[i] = o; h2[i] = o * (1.f + ml[4 * D + ch]) + ml[3 * D + ch]; }
}

__global__ void __launch_bounds__(256) k_router(const float* __restrict__ h2, const float* __restrict__ rw, const float* __restrict__ rb, int* __restrict__ eidx, float* __restrict__ ew) {
    const int row = blockIdx.x * 4 + (threadIdx.x >> 6), lane = threadIdx.x & 63; if (row >= NTOK) return;
    float acc[NE];
#pragma unroll
    for (int e = 0; e < NE; ++e) acc[e] = 0.f;
    for (int j = 0; j < 16; ++j) { const int k = lane + 64 * j; const float hv = h2[(size_t)row * D + k];
#pragma unroll
        for (int e = 0; e < NE; ++e) acc[e] += hv * rw[k * NE + e]; }
#pragma unroll
    for (int e = 0; e < NE; ++e) {
#pragma unroll
        for (int o = 32; o >= 1; o >>= 1) acc[e] += __shfl_xor(acc[e], o);
        acc[e] += rb[e]; }
    if (lane == 0) {
        float mx = acc[0]; for (int e = 1; e < NE; ++e) mx = fmaxf(mx, acc[e]);
        float sc[NE], sum = 0.f; for (int e = 0; e < NE; ++e) { sc[e] = expf(acc[e] - mx); sum += sc[e]; }
        for (int e = 0; e < NE; ++e) sc[e] /= sum;
        int best = 0; float bestv = -1.f;
        for (int gq = 0; gq < NGRP; ++gq) { float m1 = -1.f, m2 = -1.f; for (int j = 0; j < EPG; ++j) { const float v = sc[gq * EPG + j]; if (v > m1) { m2 = m1; m1 = v; } else if (v > m2) m2 = v; }
            const float gs = m1 + m2; if (gs > bestv) { bestv = gs; best = gq; } }
        int i1 = 0; float v1 = -1.f; for (int j = 0; j < EPG; ++j) { const float v = sc[best * EPG + j]; if (v > v1) { v1 = v; i1 = j; } }
        int i2 = 0; float v2 = -1.f; for (int j = 0; j < EPG; ++j) { if (j == i1) continue; const float v = sc[best * EPG + j]; if (v > v2) { v2 = v; i2 = j; } }
        const float wsum = v1 + v2;
        eidx[row * 2] = best * EPG + i1; eidx[row * 2 + 1] = best * EPG + i2; ew[row * 2] = v1 / wsum; ew[row * 2 + 1] = v2 / wsum;
    }
}

__global__ void __launch_bounds__(512) k_moe_sort(const int* __restrict__ eidx, int* __restrict__ slot_tok, int* __restrict__ tok_slot, int* __restrict__ tile_e, int* __restrict__ nslots) {
    __shared__ int cnt[512][NE + 1];
    __shared__ int ebase[NE + 1];
    const int t = threadIdx.x;
    int c[NE]; for (int e = 0; e < NE; ++e) c[e] = 0;
    for (int i = 0; i < 32; ++i) { const int tok = t * 32 + i; c[eidx[tok * 2]]++; c[eidx[tok * 2 + 1]]++; }
    for (int e = 0; e < NE; ++e) cnt[t][e] = c[e];
    __syncthreads();
    if (t < NE) { int run = 0; for (int i = 0; i < 512; ++i) { const int v = cnt[i][t]; cnt[i][t] = run; run += v; } ebase[t] = run; }
    __syncthreads();
    if (t == 0) { int run = 0; for (int e = 0; e < NE; ++e) { const int n = ebase[e], padded = (n + 255) / 256 * 256; for (int q = run / 256; q < (run + padded) / 256; ++q) tile_e[q] = e; ebase[e] = run; run += padded; } ebase[NE] = run; nslots[0] = run; }
    __syncthreads();
    for (int i = t; i < MAXSLOT; i += 512) slot_tok[i] = -1;
    __syncthreads();
    int off[NE]; for (int e = 0; e < NE; ++e) off[e] = ebase[e] + cnt[t][e];
    for (int i = 0; i < 32; ++i) { const int tok = t * 32 + i;
        for (int j = 0; j < 2; ++j) { const int e = eidx[tok * 2 + j]; const int s = off[e]++; slot_tok[s] = tok; tok_slot[tok * 2 + j] = s; } }
}

__global__ void k_swiglu(const float* __restrict__ Gv, const float* __restrict__ Uv, float* __restrict__ act, const int* __restrict__ nslots) {
    const size_t i = (size_t)blockIdx.x * blockDim.x + threadIdx.x; if (i >= (size_t)nslots[0] * FF) return;
    act[i] = silu_f(Gv[i]) * Uv[i];
}

__global__ void __launch_bounds__(256) k_moe_combine_ln(const float* __restrict__ x1, const float* __restrict__ O, const int* __restrict__ tok_slot, const float* __restrict__ ew,
                                                        const float* __restrict__ modv, const float* __restrict__ lng, const float* __restrict__ lnb, float* __restrict__ xout) {
    const int row = blockIdx.x * 4 + (threadIdx.x >> 6), lane = threadIdx.x & 63; if (row >= NTOK) return;
    const int b = row / SEQ; const float* ml = modv + (size_t)b * 6 * D;
    const int s0 = tok_slot[row * 2], s1 = tok_slot[row * 2 + 1]; const float w0 = ew[row * 2], w1 = ew[row * 2 + 1];
    float v[16]; float s = 0.f;
#pragma unroll
    for (int j = 0; j < 16; ++j) { const int ch = lane + 64 * j;
        const float m = w0 * O[(size_t)s0 * D + ch] + w1 * O[(size_t)s1 * D + ch];
        v[j] = DN_ALPHA * x1[(size_t)row * D + ch] + ml[5 * D + ch] * m; s += v[j]; }
#pragma unroll
    for (int o = 32; o >= 1; o >>= 1) s += __shfl_xor(s, o);
    const float mean = s * (1.f / D); float q = 0.f;
#pragma unroll
    for (int j = 0; j < 16; ++j) { const float d = v[j] - mean; q += d * d; }
#pragma unroll
    for (int o = 32; o >= 1; o >>= 1) q += __shfl_xor(q, o);
    const float rstd = 1.f / sqrtf(q * (1.f / D) + LN_EPS);
#pragma unroll
    for (int j = 0; j < 16; ++j) { const int ch = lane + 64 * j; xout[(size_t)row * D + ch] = (v[j] - mean) * rstd * lng[ch] + lnb[ch]; }
}

__global__ void k_pool(const float* __restrict__ x, const float* __restrict__ modv1, float* __restrict__ pooled) {
    const size_t i = (size_t)blockIdx.x * blockDim.x + threadIdx.x; if (i >= (size_t)NTOK * D) return;
    const int ch = (int)(i % D), tok = (int)(i / D), b = tok / SEQ, t = tok % SEQ, r = t / 64, cc = t % 64;
    const int gq = ch / 256, k = 2 << gq;
    const float* ml = modv1 + (size_t)b * 6 * D; const float mul = 1.f + ml[D + ch], add = ml[ch];
    const int rlo = max(r - k / 2, 0), rhi = min(r + k - k / 2, 64), clo = max(cc - k / 2, 0), chi = min(cc + k - k / 2, 64);
    float s = 0.f;
    for (int rr = rlo; rr < rhi; ++rr) for (int c2 = clo; c2 < chi; ++c2) s += x[((size_t)b * SEQ + rr * 64 + c2) * D + ch] * mul + add;
    const float mean = s / (float)((rhi - rlo) * (chi - clo));
    pooled[i] = mean - (x[i] * mul + add);
}

extern "C" void kernel_launch(void* const* d_in, const int* in_sizes, int n_in, void* d_out, int out_size, void* d_ws, size_t ws_size, hipStream_t stream) {
    const float* x = (const float*)d_in[0]; const float* c = (const float*)d_in[1]; const float* ctx = (const float*)d_in[2]; const float* c_ctx = (const float*)d_in[3];
    const float* mod_w = (const float*)d_in[4]; const float* mod_b = (const float*)d_in[5]; const float* ln_g = (const float*)d_in[6]; const float* ln_b = (const float*)d_in[7];
    const float* lam_re = (const float*)d_in[8]; const float* lam_im = (const float*)d_in[9]; const float* log_dt = (const float*)d_in[10];
    const float* b_re = (const float*)d_in[11]; const float* b_im = (const float*)d_in[12]; const float* c_re = (const float*)d_in[13]; const float* c_im = (const float*)d_in[14];
    const float* s5d = (const float*)d_in[15]; const float* w_val = (const float*)d_in[16]; const float* w_gate = (const float*)d_in[17];
    const float* pool_w = (const float*)d_in[18]; const float* pool_scale = (const float*)d_in[19]; const float* router_w = (const float*)d_in[20]; const float* router_b = (const float*)d_in[21];
    const float* moe_wg = (const float*)d_in[22]; const float* moe_wu = (const float*)d_in[23]; const float* moe_wd = (const float*)d_in[24];
    float* out = (float*)d_out;
    char* ws = (char*)d_ws; size_t off = 0;
    auto take = [&](size_t bytes) { char* p = ws + off; off += (bytes + 255) / 256 * 256; return p; };
    float* modv = (float*)take((size_t)2 * 5 * 6 * D * 4);
    float* ar = (float*)take(2 * S5G * S5P * 4); float* ai = (float*)take(2 * S5G * S5P * 4);
    float* bbr = (float*)take((size_t)2 * S5G * S5P * S5H * 4); float* bbi = (float*)take((size_t)2 * S5G * S5P * S5H * 4);
    const size_t ACT = (size_t)NTOK * D * 4, MB = 1u << 20;
    char* regA = take(144 * MB); char* regB = take(144 * MB); char* regC = take(ACT);
    float* bufA = (float*)regA; float* mG = (float*)regA;
    float* bufB = (float*)regB; float* bufV = (float*)(regB + ACT); float* mU = (float*)regB;
    float* bufG = (float*)regC; float* x2 = (float*)regC;
    float* x1 = (float*)take(ACT); float* h2 = (float*)take(ACT);
    int* eidx = (int*)take(NTOK * 2 * 4); float* ew = (float*)take(NTOK * 2 * 4);
    int* slot_tok = (int*)take(MAXSLOT * 4); int* tok_slot = (int*)take(NTOK * 2 * 4); int* tile_e = (int*)take(MAXTILE * 4); int* nslots = (int*)take(256);
    static_assert((size_t)MAXSLOT * FF * 4 <= 144u * (1u << 20), "slot buffers fit");
    if (off > ws_size) { fprintf(stderr, "workspace too small: need %zu have %zu\n", off, ws_size); return; }

    const float* modv0 = modv; const float* modv1 = modv + (size_t)5 * 6 * D;
    k_modvec<<<dim3(6 * D / 256, 2), 256, 0, stream>>>(c, c_ctx, mod_w, mod_b, modv);
    k_s5_disc<<<(2 * S5G * S5P + 255) / 256, 256, 0, stream>>>(lam_re, lam_im, log_dt, b_re, b_im, ar, ai, bbr, bbi);
    k_s5_naive<<<dim3(S5G, BATCH, 2), 64, 0, stream>>>(x, ctx, modv0, ar, ai, bbr, bbi, c_re, c_im, bufA);
    k_glu_in<<<(unsigned)(((size_t)NTOK * D + 255) / 256), 256, 0, stream>>>(x, modv0, s5d, bufA, bufB);
    k_gemm_naive<<<dim3(D / 64, NTOK / 64), 256, 0, stream>>>(bufB, D, nullptr, w_val, D, 0, nullptr, bufV, D, NTOK, D, D, nullptr, 0, 0);
    k_gemm_naive<<<dim3(D / 64, NTOK / 64), 256, 0, stream>>>(bufB, D, nullptr, w_gate, D, 0, nullptr, bufG, D, NTOK, D, D, nullptr, 0, 0);
    k_res_ln<<<NTOK / 4, 256, 0, stream>>>(x, bufV, bufG, nullptr, 0, modv0, ln_g, ln_b, x1, h2);
    const float* xin_l[2] = {x1, nullptr};
    for (int l = 0; l < 2; ++l) {
        const float* mv = l == 0 ? modv0 : modv1;
        if (l == 1) {
            k_pool<<<(unsigned)(((size_t)NTOK * D + 255) / 256), 256, 0, stream>>>(x2, modv1, bufB);
            for (int gq = 0; gq < 4; ++gq)
                k_gemm_naive<<<dim3(256 / 64, NTOK / 64), 256, 0, stream>>>(bufB, D, nullptr, pool_w + (size_t)gq * 256 * 256, 256, 0, nullptr, bufV, D, NTOK, 256, 256, nullptr, gq * 256, gq * 256);
            k_res_ln<<<NTOK / 4, 256, 0, stream>>>(x2, bufV, nullptr, pool_scale, 1, modv1, ln_g + 2 * D, ln_b + 2 * D, x1, h2);
        }
        k_router<<<NTOK / 4, 256, 0, stream>>>(h2, router_w, router_b, eidx, ew);
        k_moe_sort<<<1, 512, 0, stream>>>(eidx, slot_tok, tok_slot, tile_e, nslots);
        const size_t wstride = (size_t)D * FF;
        k_gemm_naive<<<dim3(FF / 64, MAXSLOT / 64), 256, 0, stream>>>(h2, D, slot_tok, moe_wg + (size_t)l * NE * wstride, FF, wstride, tile_e, mG, FF, MAXSLOT, FF, D, nslots, 0, 0);
        k_gemm_naive<<<dim3(FF / 64, MAXSLOT / 64), 256, 0, stream>>>(h2, D, slot_tok, moe_wu + (size_t)l * NE * wstride, FF, wstride, tile_e, mU, FF, MAXSLOT, FF, D, nslots, 0, 0);
        k_swiglu<<<(unsigned)(((size_t)MAXSLOT * FF + 255) / 256), 256, 0, stream>>>(mG, mU, mG, nslots);
        k_gemm_naive<<<dim3(D / 64, MAXSLOT / 64), 256, 0, stream>>>(mG, FF, nullptr, moe_wd + (size_t)l * NE * wstride, D, wstride, tile_e, mU, D, MAXSLOT, D, FF, nslots, 0, 0);
        k_moe_combine_ln<<<NTOK / 4, 256, 0, stream>>>(x1, mU, tok_slot, ew, mv, ln_g + (l * 2 + 1) * D, ln_b + (l * 2 + 1) * D, l == 0 ? x2 : out);
    }
    (void)xin_l; (void)in_sizes; (void)n_in; (void)out_size;
}
```

```cpp
#include <hip/hip_runtime.h>
#include <cstdio>
#include <cstdint>
#include <cmath>

#ifndef MK_PER_PHASE
#define MK_PER_PHASE 0
#endif

constexpr int D = 1024, BATCH = 4, SEQ = 4096, NTOK = BATCH * SEQ, CTXL = 256;
constexpr int S5G = 64, S5H = 16, S5P = 64, S5T = 16;
constexpr int NCHL = SEQ / S5T, NCHC = CTXL / S5T;
constexpr int NE = 16, NGRP = 4, EPG = 4, FF = 1024;
constexpr int MAXSLOT = 2 * NTOK + NE * 256, MAXTILE = MAXSLOT / 256;
constexpr float DN_ALPHA = 1.4142135623730951f;
constexpr float LN_EPS = 1e-5f;
constexpr int NWAVES = 8, NTHR = 512, NWG = 256;

constexpr size_t MiB = 1u << 20;
constexpr size_t WS_CTL = 0, CTL_ZERO_BYTES = 64 * 1024;
constexpr size_t WS_MODV = 1 * MiB;
constexpr size_t WS_EIDX = WS_MODV + 256 * 1024;
constexpr size_t WS_EW = WS_EIDX + 128 * 1024;
constexpr size_t WS_TOKSLOT = WS_EW + 128 * 1024;
constexpr size_t WS_SLOTTOK = WS_TOKSLOT + 128 * 1024;
constexpr size_t WS_CNT = WS_SLOTTOK + 160 * 1024;
constexpr size_t WS_TILEE = WS_CNT + 16 * 1024;
constexpr size_t WS_WVG = 4 * MiB;
constexpr size_t WS_WP = 8 * MiB;
constexpr size_t WS_WGU = 16 * MiB;
constexpr size_t WS_WD = 144 * MiB;
constexpr size_t WS_T = 208 * MiB;
constexpr size_t WS_WIN = WS_T, WS_WY = WS_T + 8 * MiB, WS_HT = WS_T + 24 * MiB, WS_Y = WS_T + 56 * MiB;
constexpr size_t WS_ACT = WS_T;
constexpr size_t WS_HP = WS_T, WS_Z = WS_T + 32 * MiB, WS_HS = WS_T + 64 * MiB;
constexpr size_t WS_U = 304 * MiB;
constexpr size_t WS_X1 = 376 * MiB;
constexpr size_t WS_H2 = 440 * MiB;
constexpr size_t WS_END = 472 * MiB;
constexpr int LDS_BYTES = 163840;
constexpr int LDS_MISC = 163840 - 256;

#define GAS __attribute__((address_space(1)))
#define LAS __attribute__((address_space(3)))
typedef unsigned short bf16;
typedef short bf16x8 __attribute__((ext_vector_type(8)));
typedef float f32x4 __attribute__((ext_vector_type(4)));
typedef float f32x2 __attribute__((ext_vector_type(2)));
typedef unsigned u32x4 __attribute__((ext_vector_type(4)));
typedef unsigned u32x2 __attribute__((ext_vector_type(2)));

__device__ __forceinline__ unsigned cvt_pk_bf16(float lo, float hi) { unsigned r; asm volatile("v_cvt_pk_bf16_f32 %0, %1, %2" : "=v"(r) : "v"(lo), "v"(hi)); return r; }
__device__ __forceinline__ float bf_lo(unsigned w) { return __uint_as_float(w << 16); }
__device__ __forceinline__ float bf_hi(unsigned w) { return __uint_as_float(w & 0xffff0000u); }
__device__ __forceinline__ float silu_f(float v) { return v / (1.f + __expf(-v)); }
__device__ __forceinline__ float sigmoid_f(float v) { return 1.f / (1.f + __expf(-v)); }
__device__ __forceinline__ float gelu_tanh_f(float v) { const float u = 1.5957691216057308f * (v + 0.044715f * v * v * v); return v / (1.f + __expf(-u)); }
__device__ __forceinline__ float wave_sum(float v) {
#pragma unroll
    for (int o = 1; o < 64; o <<= 1) v += __shfl_xor(v, o);
    return v;
}

#define XB_TMO      128
#define XB_XCNT(j)  (256  + 64 * (j))
#define XB_XSUB(j)  (1280 + 64 * (j))
#define XB_XGEN(j)  (2304 + 64 * (j))
#define XB_TOP      3328
#define XB_TOPGEN   3392
#define XCD_BAR_WORDS 3456
#define XB_SPIN_CAP (1u << 18)
__device__ __forceinline__ unsigned xb_ld(unsigned* p)              { return __hip_atomic_load(p, __ATOMIC_RELAXED, __HIP_MEMORY_SCOPE_AGENT); }
__device__ __forceinline__ unsigned xb_add(unsigned* p, unsigned v) { return __hip_atomic_fetch_add(p, v, __ATOMIC_RELAXED, __HIP_MEMORY_SCOPE_AGENT); }
__device__ __forceinline__ unsigned xb_xcc_id() { return (unsigned)__builtin_amdgcn_s_getreg((3 << 11) | 20) & 0xFu; }
#define XB_SPIN(cond, bar) do { unsigned _sp = 0; while (cond) { __builtin_amdgcn_s_sleep(1); \
    if ((++_sp & 255u) == 0u) { if (xb_ld(&(bar)[XB_TMO])) break; if (_sp > XB_SPIN_CAP) { atomicAdd(&(bar)[XB_TMO], 1u); break; } } } } while (0)
struct XcdBarrier { unsigned* bar; unsigned x; volatile LAS unsigned* st; };
__device__ __forceinline__ XcdBarrier xcd_barrier_post(unsigned* bar, volatile LAS unsigned* st) {
    XcdBarrier b; b.bar = bar; b.x = xb_xcc_id(); b.st = st;
    if (threadIdx.x == 0) (void)xb_add(&bar[XB_XCNT(b.x)], 1u);
    return b;
}
__device__ __forceinline__ void xcd_barrier_complete(unsigned* bar, unsigned x, unsigned& nloc, unsigned& nx) {
    const unsigned G = gridDim.x * gridDim.y * gridDim.z;
    unsigned sum, cnt, mine, sp = 0u;
    for (;;) {
        sum = 0u; cnt = 0u; mine = 0u;
#pragma unroll
        for (unsigned j = 0; j < 16; ++j) { const unsigned c = xb_ld(&bar[XB_XCNT(j)]); sum += c; cnt += (c > 0u) ? 1u : 0u; mine = (j == x) ? c : mine; }
        if (sum == G) break;
        __builtin_amdgcn_s_sleep(1);
        if ((++sp & 255u) == 0u) { if (xb_ld(&bar[XB_TMO])) break; if (sp > XB_SPIN_CAP) { atomicAdd(&bar[XB_TMO], 1u); break; } }
    }
    nloc = mine > 0u ? mine : 1u; nx = cnt > 0u ? cnt : 1u;
}
__device__ __forceinline__ void xcd_barrier(const XcdBarrier& b) {
    asm volatile("s_waitcnt vmcnt(0)" ::: "memory");
    __syncthreads();
    if (threadIdx.x == 0) {
        unsigned* bar = b.bar;
        __builtin_amdgcn_s_waitcnt(0);
        unsigned nloc = b.st[0], nx = b.st[1];
        if (nloc == 0u) { xcd_barrier_complete(bar, b.x, nloc, nx); b.st[0] = nloc; b.st[1] = nx; }
        const unsigned old = xb_add(&bar[XB_XSUB(b.x)], 1u);
        const unsigned gen = old / nloc;
        if (old + 1u == (gen + 1u) * nloc) {
            __builtin_amdgcn_fence(__ATOMIC_RELEASE, "agent");
            asm volatile("s_waitcnt vmcnt(0)" ::: "memory");
            const unsigned og = xb_add(&bar[XB_TOP], 1u);
            const unsigned tg = og / nx;
            if (og + 1u == (tg + 1u) * nx) xb_add(&bar[XB_TOPGEN], 1u);
            else XB_SPIN(xb_ld(&bar[XB_TOPGEN]) == tg, bar);
            __builtin_amdgcn_fence(__ATOMIC_ACQUIRE, "agent");
            xb_add(&bar[XB_XGEN(b.x)], 1u);
            asm volatile("s_waitcnt vmcnt(0)" ::: "memory");
        } else {
            XB_SPIN(xb_ld(&bar[XB_XGEN(b.x)]) == gen, bar);
            __builtin_amdgcn_fence(__ATOMIC_ACQUIRE, "agent");
            asm volatile("s_waitcnt vmcnt(0)" ::: "memory");
        }
    }
    __syncthreads();
}

namespace pg8 {
constexpr int BM = 256, BK = 64, HALF = 128, HTB = HALF * BK * 2, STAGE_BYTES = 8 * HTB, NXCD = 8, WGM = 8;
__host__ __device__ __forceinline__ int lds_byte(int r, int c) { const int st = (r >> 4) * 2 + (c >> 5), rr = r & 15, cc = c & 31, ob = rr * 64 + cc * 2; return st * 1024 + (ob ^ (((ob >> 9) & 1) << 5)); }
__host__ __device__ __forceinline__ void stage_rc(int b, int& R, int& C) { const int st = b / 1024, sb = b % 1024, swz = sb ^ (((sb >> 9) & 1) << 5); R = (st >> 1) * 16 + swz / 64; C = (st & 1) * 32 + (swz % 64) / 2; }
__host__ __device__ __forceinline__ int perm32(int rho) { const int n = rho >> 4, i = rho & 15; return 8 * (i >> 2) + 4 * n + (i & 3); }

struct Unit { int pm, pn, pb; };

struct ARows {
    const char* base; int ld; int coltile;
    static constexpr bool GATHER = false; static constexpr unsigned kstep = BK * 2;
    __device__ __forceinline__ const char* ubase(const Unit& u) const { return base + ((size_t)(u.pm * BM) * ld + u.pn * coltile) * 2; }
    __device__ __forceinline__ unsigned hstep() const { return (unsigned)(HALF * ld * 2); }
    __device__ __forceinline__ unsigned lane_off(int R, int C) const { return (unsigned)((R * ld + C) * 2); }
    __device__ __forceinline__ unsigned off(const Unit&, int, int, int) const { return 0u; }
};
struct AGather {
    const char* base; int ld; const int* map;
    static constexpr bool GATHER = true; static constexpr unsigned kstep = BK * 2;
    __device__ __forceinline__ const char* ubase(const Unit&) const { return base; }
    __device__ __forceinline__ unsigned hstep() const { return 0u; }
    __device__ __forceinline__ unsigned lane_off(int, int) const { return 0u; }
    __device__ __forceinline__ unsigned off(const Unit& u, int h, int R, int C) const { return (unsigned)((map[u.pm * BM + h * HALF + R] * ld + C) * 2); }
};
struct AGroupMajor {
    const char* base;
    static constexpr bool GATHER = false; static constexpr unsigned kstep = 4u * NTOK * 32u;
    __device__ __forceinline__ const char* ubase(const Unit& u) const { return base + (size_t)(u.pm * BM) * 32; }
    __device__ __forceinline__ unsigned hstep() const { return (unsigned)(HALF * 32); }
    __device__ __forceinline__ unsigned lane_off(int R, int C) const { return (unsigned)((((C >> 4) * NTOK + R) * 32) + (C & 15) * 2); }
    __device__ __forceinline__ unsigned off(const Unit&, int, int, int) const { return 0u; }
};

struct StaticOrder {
    int nM, nN, nwg, G, c;
    __device__ void init(int M, int N, int G_, int c_) { nM = M / BM; nN = N / BM; nwg = nM * nN; G = G_; c = c_; }
    __device__ bool next(int i, Unit& u) const {
        const long L = (long)i * G + c; if (L >= nwg) return false;
        int wgid = (int)L; { const int q = nwg / NXCD, r = nwg % NXCD, xcd = wgid % NXCD, off = wgid / NXCD; wgid = (xcd < r ? xcd * (q + 1) : r * (q + 1) + (xcd - r) * q) + off; }
        const int nig = WGM * nN, gid = wgid / nig, fm = gid * WGM, gsz = (nM - fm) < WGM ? (nM - fm) : WGM;
        u.pm = fm + ((wgid % nig) % gsz); u.pn = (wgid % nig) / gsz; u.pb = u.pn; return true;
    }
};
struct MoeOrder {
    const int* tile_e; int ntiles, nN, G, c;
    __device__ bool next(int i, Unit& u) const {
        const int nwg = ntiles * nN; const long L = (long)i * G + c; if (L >= nwg) return false;
        int wgid = (int)L; { const int q = nwg / NXCD, r = nwg % NXCD, xcd = wgid % NXCD, off = wgid / NXCD; wgid = (xcd < r ? xcd * (q + 1) : r * (q + 1) + (xcd - r) * q) + off; }
        u.pm = wgid / nN; u.pn = wgid % nN; u.pb = tile_e[u.pm] * nN + u.pn; return true;
    }
};

template <class Epi, class Sched, class ALay>
__device__ __forceinline__ void gemm_phase(LAS unsigned char* lds, const ALay AL, const bf16* Bt, const int K_, const Sched& S, const Epi& E) {
    int K = K_; asm volatile("" : "+s"(K));
    const int tid = threadIdx.x, wid = __builtin_amdgcn_readfirstlane(tid >> 6), lane = tid & 63, wr = wid >> 2, wc = wid & 3, fr = lane & 15, fq = lane >> 4;
    const int nt = K / BK;
    unsigned voffB[2], voffA[2][2];
#pragma unroll
    for (int i = 0; i < 2; ++i) { int R, C; stage_rc(tid * 16 + i * 8192, R, C); const int Rb = Epi::PERM ? ((R & ~31) + perm32(R & 31)) : R; voffB[i] = (unsigned)(Rb * K + C) * 2u; voffA[0][i] = AL.lane_off(R, C); voffA[1][i] = voffA[0][i]; }
    const size_t kstepB = (size_t)(BK * 2), hstep = (size_t)HALF * K * 2, tstep = 2 * hstep;
    const size_t kstepA = (size_t)ALay::kstep, hstepA = (size_t)AL.hstep();
    constexpr int H1 = ALay::GATHER ? 1 : 0;
    const unsigned ldsw = (unsigned)wid * 1024u;
    const int aoff = lds_byte(wr * 64 + fr, fq * 8), boff = lds_byte(wc * 32 + fr, fq * 8);
#define PG8_SA(b, h) (((b) * 2 + (h)) * HTB)
#define PG8_SB(b, h) ((4 + (b) * 2 + (h)) * HTB)
#define PG8_STAGE(bufoff, gbase, voff) do { _Pragma("unroll") for (int _i = 0; _i < 2; ++_i) \
        __builtin_amdgcn_global_load_lds((const unsigned*)((const char*)(gbase) + (voff)[_i]), (LAS unsigned*)(lds + (bufoff) + ldsw + _i * 8192), 16, 0, 0); } while (0)
#define PG8_LDA(dst, b, h) do { _Pragma("unroll") for (int m = 0; m < 4; ++m) _Pragma("unroll") for (int k = 0; k < 2; ++k) dst[m][k] = *(const LAS bf16x8*)(lds + PG8_SA(b, h) + aoff + m * 2048 + k * 1024); } while (0)
#define PG8_LDB(dst, b, h) do { _Pragma("unroll") for (int n = 0; n < 2; ++n) _Pragma("unroll") for (int k = 0; k < 2; ++k) dst[n][k] = *(const LAS bf16x8*)(lds + PG8_SB(b, h) + boff + n * 2048 + k * 1024); } while (0)
#define PG8_MMA(ai, bj, At, Bt_) do { __builtin_amdgcn_s_setprio(1); _Pragma("unroll") for (int m = 0; m < 4; ++m) _Pragma("unroll") for (int n = 0; n < 2; ++n) _Pragma("unroll") for (int k = 0; k < 2; ++k) \
        acc[ai][bj][m][n] = __builtin_amdgcn_mfma_f32_16x16x32_bf16(Bt_[n][k], At[m][k], acc[ai][bj][m][n], 0, 0, 0); __builtin_amdgcn_s_setprio(0); } while (0)
#define PG8_WAIT_V(n) asm volatile("s_waitcnt vmcnt(" #n ")" ::: "memory")
#define PG8_WAIT_L(n) asm volatile("s_waitcnt lgkmcnt(" #n ")" ::: "memory")
#define PG8_BAR __builtin_amdgcn_s_barrier()
#define PG8_SCHED __builtin_amdgcn_sched_barrier(0)
    Unit cur, nxt; int ui = 0;
    if (!S.next(0, cur)) return;
    f32x4 acc[2][2][4][2];
#pragma unroll
    for (int a = 0; a < 2; ++a)
#pragma unroll
        for (int b = 0; b < 2; ++b)
#pragma unroll
            for (int m = 0; m < 4; ++m)
#pragma unroll
                for (int n = 0; n < 2; ++n) acc[a][b][m][n] = (f32x4){0.f, 0.f, 0.f, 0.f};
    bf16x8 At[4][2], B0[2][2], B1[2][2];
    unsigned nvA[2][2];
    if constexpr (ALay::GATHER) {
#pragma unroll
        for (int h = 0; h < 2; ++h)
#pragma unroll
            for (int i = 0; i < 2; ++i) { int R, C; stage_rc(tid * 16 + i * 8192, R, C); voffA[h][i] = AL.off(cur, h, R, C); nvA[h][i] = voffA[h][i]; }
    }
    const char* cA = AL.ubase(cur);
    const char* cB = (const char*)Bt + (size_t)cur.pb * tstep;
    PG8_STAGE(PG8_SB(0, 0), cB, voffB); PG8_STAGE(PG8_SB(0, 1), cB + hstep, voffB); PG8_STAGE(PG8_SA(0, 0), cA, voffA[0]); PG8_STAGE(PG8_SA(0, 1), cA + hstepA, voffA[H1]);
    if (wr == 1) PG8_BAR;
    PG8_WAIT_V(2); PG8_BAR;
    PG8_STAGE(PG8_SB(1, 0), cB + kstepB, voffB); PG8_STAGE(PG8_SA(1, 0), cA + kstepA, voffA[0]); PG8_STAGE(PG8_SB(1, 1), cB + hstep + kstepB, voffB);
    PG8_WAIT_V(6); PG8_BAR;
    for (;;) {
        const bool has_next = S.next(ui + 1, nxt);
        const char* nB = has_next ? (const char*)Bt + (size_t)nxt.pb * tstep : cB;
        const char* nA = has_next ? AL.ubase(nxt) : cA;
        for (int t = 0; t < nt; t += 2) {
            const bool last = (t == nt - 2);
            if constexpr (ALay::GATHER) { if (t == nt - 4 && has_next) {
#pragma unroll
                for (int h = 0; h < 2; ++h)
#pragma unroll
                    for (int i = 0; i < 2; ++i) { int R, C; stage_rc(tid * 16 + i * 8192, R, C); nvA[h][i] = AL.off(nxt, h, R, C); }
            } }
            const char* a1 = cA + (size_t)(t + 1) * kstepA;
            const char* a2 = last ? nA : cA + (size_t)(t + 2) * kstepA; const char* b2 = last ? nB : cB + (size_t)(t + 2) * kstepB;
            const char* a3 = a2 + kstepA; const char* b3 = b2 + kstepB;
            PG8_LDB(B0, 0, 0); PG8_LDB(B1, 0, 1); PG8_SCHED; PG8_LDA(At, 0, 0); PG8_STAGE(PG8_SA(1, 1), a1 + hstepA, voffA[H1]);
            PG8_WAIT_V(8); PG8_WAIT_L(0); PG8_BAR; PG8_MMA(0, 0, At, B0); PG8_MMA(0, 1, At, B1); PG8_BAR; PG8_SCHED;
            if constexpr (ALay::GATHER) { if (last) {
#pragma unroll
                for (int h = 0; h < 2; ++h)
#pragma unroll
                    for (int i = 0; i < 2; ++i) voffA[h][i] = nvA[h][i];
            } }
            PG8_LDA(At, 0, 1); PG8_STAGE(PG8_SB(0, 0), b2, voffB); PG8_STAGE(PG8_SB(0, 1), b2 + hstep, voffB); PG8_STAGE(PG8_SA(0, 0), a2, voffA[0]);
            PG8_WAIT_V(8); PG8_WAIT_L(0); PG8_BAR; PG8_MMA(1, 0, At, B0); PG8_MMA(1, 1, At, B1); PG8_BAR; PG8_SCHED;
            PG8_LDB(B0, 1, 0); PG8_LDB(B1, 1, 1); PG8_SCHED; PG8_LDA(At, 1, 0); PG8_STAGE(PG8_SA(0, 1), a2 + hstepA, voffA[H1]);
            PG8_WAIT_V(8); PG8_WAIT_L(0); PG8_BAR; PG8_MMA(0, 0, At, B0); PG8_MMA(0, 1, At, B1); PG8_BAR; PG8_SCHED;
            PG8_LDA(At, 1, 1); PG8_STAGE(PG8_SB(1, 0), b3, voffB); PG8_STAGE(PG8_SB(1, 1), b3 + hstep, voffB); PG8_STAGE(PG8_SA(1, 0), a3, voffA[0]);
            PG8_WAIT_V(8); PG8_WAIT_L(0); PG8_BAR; PG8_MMA(1, 0, At, B0); PG8_MMA(1, 1, At, B1); PG8_BAR; PG8_SCHED;
        }
        if (wr == 0) PG8_BAR;
        E(acc, cur, wr, wc, fr, fq);
        if (!has_next) break;
#pragma unroll
        for (int a = 0; a < 2; ++a)
#pragma unroll
            for (int b = 0; b < 2; ++b)
#pragma unroll
                for (int m = 0; m < 4; ++m)
#pragma unroll
                    for (int n = 0; n < 2; ++n) acc[a][b][m][n] = (f32x4){0.f, 0.f, 0.f, 0.f};
        cur = nxt; cB = nB; cA = nA; ++ui;
        if (wr == 1) PG8_BAR;
    }
    PG8_WAIT_V(0);
    PG8_BAR;
#undef PG8_SA
#undef PG8_SB
#undef PG8_STAGE
#undef PG8_LDA
#undef PG8_LDB
#undef PG8_MMA
#undef PG8_WAIT_V
#undef PG8_WAIT_L
#undef PG8_BAR
#undef PG8_SCHED
}

struct EpiGlu {
    static constexpr bool PERM = false;
    const float* x; const float* modv; float* R1;
    __device__ __forceinline__ void operator()(const f32x4 (&acc)[2][2][4][2], const Unit& u, int wr, int wc, int fr, int fq) const {
        const int row0 = u.pm * BM + wr * 64 + fr, col0 = u.pn * HALF + wc * 32 + 4 * fq, b = (u.pm * BM) / SEQ;
        f32x4 g1[2];
#pragma unroll
        for (int n = 0; n < 2; ++n) g1[n] = *(const f32x4*)(modv + (size_t)b * 6 * D + 2 * D + col0 + 16 * n);
#pragma unroll
        for (int ai = 0; ai < 2; ++ai)
#pragma unroll
            for (int m = 0; m < 4; ++m) { const size_t ro = (size_t)(row0 + ai * HALF + m * 16) * D + col0;
#pragma unroll
                for (int n = 0; n < 2; ++n) { const f32x4 xv = *(const f32x4*)(x + ro + 16 * n), v = acc[ai][0][m][n], gt = acc[ai][1][m][n]; f32x4 o;
#pragma unroll
                    for (int j = 0; j < 4; ++j) o[j] = DN_ALPHA * xv[j] + g1[n][j] * (v[j] * sigmoid_f(gt[j]));
                    *(f32x4*)(R1 + ro + 16 * n) = o; } }
    }
};
struct EpiSwiglu {
    static constexpr bool PERM = true;
    bf16* ACT;
    __device__ __forceinline__ void operator()(const f32x4 (&acc)[2][2][4][2], const Unit& u, int wr, int wc, int fr, int fq) const {
        const int row0 = u.pm * BM + wr * 64 + fr, col0 = u.pn * HALF + wc * 32 + 8 * fq;
#pragma unroll
        for (int ai = 0; ai < 2; ++ai)
#pragma unroll
            for (int m = 0; m < 4; ++m) { float v[8];
#pragma unroll
                for (int n = 0; n < 2; ++n)
#pragma unroll
                    for (int j = 0; j < 4; ++j) v[4 * n + j] = silu_f(acc[ai][0][m][n][j]) * acc[ai][1][m][n][j];
                u32x4 w; w.x = cvt_pk_bf16(v[0], v[1]); w.y = cvt_pk_bf16(v[2], v[3]); w.z = cvt_pk_bf16(v[4], v[5]); w.w = cvt_pk_bf16(v[6], v[7]);
                *(u32x4*)(ACT + (size_t)(row0 + ai * HALF + m * 16) * FF + col0) = w; }
    }
};
struct EpiBf16 {
    static constexpr bool PERM = true;
    bf16* O; int ldc;
    __device__ __forceinline__ void operator()(const f32x4 (&acc)[2][2][4][2], const Unit& u, int wr, int wc, int fr, int fq) const {
        const int row0 = u.pm * BM + wr * 64 + fr, col0 = u.pn * BM + wc * 32 + 8 * fq;
#pragma unroll
        for (int ai = 0; ai < 2; ++ai)
#pragma unroll
            for (int m = 0; m < 4; ++m) { bf16* rowp = O + (size_t)(row0 + ai * HALF + m * 16) * ldc + col0;
#pragma unroll
                for (int bj = 0; bj < 2; ++bj) { const f32x4 v0 = acc[ai][bj][m][0], v1 = acc[ai][bj][m][1];
                    u32x4 w; w.x = cvt_pk_bf16(v0[0], v0[1]); w.y = cvt_pk_bf16(v0[2], v0[3]); w.z = cvt_pk_bf16(v1[0], v1[1]); w.w = cvt_pk_bf16(v1[2], v1[3]);
                    *(u32x4*)(rowp + bj * HALF) = w; } }
    }
};
}
struct Args { const float* in[25]; float* out; unsigned char* ws; int ph_lo, ph_hi; };
enum { I_X = 0, I_C, I_CTX, I_CCTX, I_MODW, I_MODB, I_LNG, I_LNB, I_LAMRE, I_LAMIM, I_LOGDT, I_BRE, I_BIM, I_CRE, I_CIM, I_S5D, I_WVAL, I_WGATE, I_POOLW, I_POOLS, I_RW, I_RB, I_MWG, I_MWU, I_MWD };

struct Frame {
    LAS unsigned char* lds;
    int tid, lane, wave, bid, G;
    const Args* a;
    unsigned char* ws;
};

__device__ __forceinline__ void p0_modvec_item(Frame& F, int item) {
    const int l = item / 96, cb = item % 96;
    LAS float* sv = (LAS float*)F.lds;
    LAS float* red = (LAS float*)(F.lds + 5 * D * 4);
    const float* c = F.a->in[I_C]; const float* cc = F.a->in[I_CCTX];
    for (int i = F.tid; i < 5 * D; i += NTHR) { const int r = i / D, k = i % D; const float v = r < 4 ? c[r * D + k] : cc[k]; sv[i] = v / (1.f + expf(-v)); }
    __syncthreads();
    const int q = F.tid & 15, ks = F.tid >> 4;
    const float* w = F.a->in[I_MODW] + (size_t)l * D * 6 * D + cb * 64 + q * 4;
    f32x4 acc[5];
#pragma unroll
    for (int r = 0; r < 5; ++r) acc[r] = (f32x4){0.f, 0.f, 0.f, 0.f};
#pragma unroll 8
    for (int p = 0; p < 32; ++p) { const int k = p * 32 + ks; const f32x4 wv = *(const f32x4*)(w + (size_t)k * 6 * D);
#pragma unroll
        for (int r = 0; r < 5; ++r) acc[r] += wv * sv[r * D + k]; }
#pragma unroll
    for (int r = 0; r < 5; ++r) *(LAS f32x4*)(red + (ks * 5 + r) * 64 + q * 4) = acc[r];
    __syncthreads();
    if (F.tid < 320) { const int r = F.tid / 64, col = F.tid % 64; float s = 0.f;
        for (int k2 = 0; k2 < 32; ++k2) s += red[(k2 * 5 + r) * 64 + col];
        float* modv = (float*)(F.ws + WS_MODV);
        modv[((size_t)l * 5 + r) * 6 * D + cb * 64 + col] = s + F.a->in[I_MODB][l * 6 * D + cb * 64 + col]; }
    __syncthreads();
}

__device__ __forceinline__ void p0_s5tab_item(Frame& F, int g) {
    LAS float* pw = (LAS float*)F.lds;
    LAS float* Bb = (LAS float*)(F.lds + 17408);
    LAS float* Cc = (LAS float*)(F.lds + 17408 + 16384);
    LAS float* Kt = (LAS float*)(F.lds + 17408 + 32768);
    const float* lam_re = F.a->in[I_LAMRE]; const float* lam_im = F.a->in[I_LAMIM]; const float* log_dt = F.a->in[I_LOGDT];
    const float* b_re = F.a->in[I_BRE]; const float* b_im = F.a->in[I_BIM]; const float* c_re = F.a->in[I_CRE]; const float* c_im = F.a->in[I_CIM];
    if (F.tid < 128) {
        const int dir = F.tid >> 6, p = F.tid & 63, idx = (dir * S5G + g) * S5P + p;
        const float lr = lam_re[idx], li = lam_im[idx], dt = expf(log_dt[dir * S5G + g]);
        for (int n = 0; n <= 16; ++n) { const float mag = expf(lr * dt * (float)n), ang = li * dt * (float)n; pw[((dir * 64 + p) * 17 + n) * 2] = mag * cosf(ang); pw[((dir * 64 + p) * 17 + n) * 2 + 1] = mag * sinf(ang); }
        const float a_r = pw[((dir * 64 + p) * 17 + 1) * 2], a_i = pw[((dir * 64 + p) * 17 + 1) * 2 + 1];
        const float den = lr * lr + li * li, nr = a_r - 1.f, fr = (nr * lr + a_i * li) / den, fi = (a_i * lr - nr * li) / den;
        for (int h = 0; h < S5H; ++h) { const float br = b_re[(size_t)idx * S5H + h], bi = b_im[(size_t)idx * S5H + h];
            Bb[((dir * 64 + p) * 16 + h) * 2] = fr * br - fi * bi; Bb[((dir * 64 + p) * 16 + h) * 2 + 1] = fr * bi + fi * br; }
    }
    for (int i = F.tid; i < 2 * 16 * 64; i += NTHR) { const int dir = i >> 10, h = (i >> 6) & 15, p = i & 63; const size_t s = ((size_t)(dir * S5G + g) * S5H + h) * S5P + p;
        Cc[i * 2] = c_re[s]; Cc[i * 2 + 1] = c_im[s]; }
    __syncthreads();
    const float* dsk = F.a->in[I_S5D] + g * 16;
    for (int e = F.tid; e < 31 * 256; e += NTHR) { const int tau = e / 256 - 15, i = (e >> 4) & 15, j = e & 15; float s = 0.f;
        if (tau >= 0) for (int p = 0; p < 64; ++p) { const float cr = Cc[((0 * 16 + i) * 64 + p) * 2], ci = Cc[((0 * 16 + i) * 64 + p) * 2 + 1], ar = pw[((0 * 64 + p) * 17 + tau) * 2], ai = pw[((0 * 64 + p) * 17 + tau) * 2 + 1];
            const float zr = cr * ar - ci * ai, zi = cr * ai + ci * ar; s += zr * Bb[((0 * 64 + p) * 16 + j) * 2] - zi * Bb[((0 * 64 + p) * 16 + j) * 2 + 1]; }
        if (tau <= 0) for (int p = 0; p < 64; ++p) { const float cr = Cc[((1 * 16 + i) * 64 + p) * 2], ci = Cc[((1 * 16 + i) * 64 + p) * 2 + 1], ar = pw[((1 * 64 + p) * 17 - tau) * 2], ai = pw[((1 * 64 + p) * 17 - tau) * 2 + 1];
            const float zr = cr * ar - ci * ai, zi = cr * ai + ci * ar; s += zr * Bb[((1 * 64 + p) * 16 + j) * 2] - zi * Bb[((1 * 64 + p) * 16 + j) * 2 + 1]; }
        if (tau == 0 && i == j) s += dsk[i];
        Kt[e] = s; }
    __syncthreads();
    bf16* WIN = (bf16*)(F.ws + WS_WIN) + (size_t)g * 256 * 256;
    for (int pc = F.tid; pc < 256 * 32; pc += NTHR) { const int n = pc >> 5, k0 = (pc & 31) * 8, s = k0 >> 4, j0 = k0 & 15;
        const int w = n >> 5, ri = (n >> 4) & 1, pl = n & 15, dir = w >> 2, p = (w & 3) * 16 + pl, e = dir == 0 ? 15 - s : s;
        const float ar = pw[((dir * 64 + p) * 17 + e) * 2], ai = pw[((dir * 64 + p) * 17 + e) * 2 + 1]; float v[8];
#pragma unroll
        for (int j = 0; j < 8; ++j) { const float br = Bb[((dir * 64 + p) * 16 + j0 + j) * 2], bi = Bb[((dir * 64 + p) * 16 + j0 + j) * 2 + 1]; v[j] = ri == 0 ? ar * br - ai * bi : ar * bi + ai * br; }
        u32x4 o; o.x = cvt_pk_bf16(v[0], v[1]); o.y = cvt_pk_bf16(v[2], v[3]); o.z = cvt_pk_bf16(v[4], v[5]); o.w = cvt_pk_bf16(v[6], v[7]);
        *(u32x4*)(WIN + (size_t)n * 256 + k0) = o; }
    bf16* WY = (bf16*)(F.ws + WS_WY) + (size_t)g * 256 * 512;
    for (int pc = F.tid; pc < 256 * 64; pc += NTHR) { const int n = pc >> 6, k0 = (pc & 63) * 8, t = n >> 4, i = n & 15; float v[8];
        if (k0 < 256) { const int s = k0 >> 4, j0 = k0 & 15;
#pragma unroll
            for (int j = 0; j < 8; ++j) v[j] = Kt[((t - s + 15) * 16 + i) * 16 + j0 + j]; }
        else { const int kk = k0 - 256, w = kk >> 5, pl0 = (kk & 31) >> 1, dir = w >> 2, e = dir == 0 ? t + 1 : 16 - t;
#pragma unroll
            for (int q = 0; q < 4; ++q) { const int p = (w & 3) * 16 + pl0 + q; const float cr = Cc[((dir * 16 + i) * 64 + p) * 2], ci = Cc[((dir * 16 + i) * 64 + p) * 2 + 1], ar = pw[((dir * 64 + p) * 17 + e) * 2], ai = pw[((dir * 64 + p) * 17 + e) * 2 + 1];
                v[2 * q] = cr * ar - ci * ai; v[2 * q + 1] = -(cr * ai + ci * ar); } }
        u32x4 o; o.x = cvt_pk_bf16(v[0], v[1]); o.y = cvt_pk_bf16(v[2], v[3]); o.z = cvt_pk_bf16(v[4], v[5]); o.w = cvt_pk_bf16(v[6], v[7]);
        *(u32x4*)(WY + (size_t)n * 512 + k0) = o; }
    __syncthreads();
}

struct TrItem { const float* src; bf16* dst; int ldn, ldk; };
__device__ __forceinline__ void tr_decode(const Frame& F, int it, TrItem& T) {
    const Args& a = *F.a;
    if (it < 128) { const int mat = it >> 6, t = it & 63, kb = t >> 3, nb = t & 7;
        T.src = a.in[mat == 0 ? I_WVAL : I_WGATE] + (size_t)kb * 128 * D + nb * 128; T.ldn = D; T.ldk = D;
        T.dst = (bf16*)(F.ws + WS_WVG) + (size_t)(nb * 256 + mat * 128) * D + kb * 128; return; }
    it -= 128;
    if (it < 16) { const int gq = it >> 2, kb = (it >> 1) & 1, nb = it & 1;
        T.src = a.in[I_POOLW] + (size_t)gq * 65536 + (size_t)kb * 128 * 256 + nb * 128; T.ldn = 256; T.ldk = 256;
        T.dst = (bf16*)(F.ws + WS_WP) + (size_t)gq * 65536 + (size_t)(nb * 128) * 256 + kb * 128; return; }
    it -= 16;
    const int le = it / 192, r = it % 192, mat = r >> 6, t = r & 63, kb = t >> 3, nb = t & 7;
    T.ldn = 1024; T.ldk = 1024;
    if (mat < 2) { T.src = a.in[mat == 0 ? I_MWG : I_MWU] + (size_t)le * D * FF + (size_t)kb * 128 * FF + nb * 128;
        T.dst = (bf16*)(F.ws + WS_WGU) + (size_t)le * 2048 * 1024 + (size_t)(nb * 256 + mat * 128) * 1024 + kb * 128; }
    else { T.src = a.in[I_MWD] + (size_t)le * FF * D + (size_t)kb * 128 * D + nb * 128;
        T.dst = (bf16*)(F.ws + WS_WD) + (size_t)le * 1024 * 1024 + (size_t)(nb * 128) * 1024 + kb * 128; }
}
constexpr int N_TR_ITEMS = 128 + 16 + 32 * 192;
__device__ __forceinline__ void tr_load(const Frame& F, const TrItem& T, f32x4 (&v)[8]) {
    const int n4 = F.tid & 31, kr = F.tid >> 5;
#pragma unroll
    for (int p = 0; p < 4; ++p) { const int kp = kr + 16 * p; const float* s = T.src + (size_t)(2 * kp) * T.ldn + n4 * 4;
        v[2 * p] = *(const f32x4*)s; v[2 * p + 1] = *(const f32x4*)(s + T.ldn); }
}
__device__ __forceinline__ void tr_put(const Frame& F, LAS unsigned* buf, const f32x4 (&v)[8]) {
    const int n4 = F.tid & 31, kr = F.tid >> 5;
#pragma unroll
    for (int p = 0; p < 4; ++p) { const int kp = kr + 16 * p;
#pragma unroll
        for (int j = 0; j < 4; ++j) buf[(n4 * 4 + j) * 64 + (kp ^ n4)] = cvt_pk_bf16(v[2 * p][j], v[2 * p + 1][j]); }
}
__device__ __forceinline__ void tr_get(const Frame& F, const LAS unsigned* buf, const TrItem& T) {
#pragma unroll
    for (int p = 0; p < 4; ++p) { const int pc = F.tid + p * NTHR, n = pc >> 4, q = pc & 15, sw = (n >> 2) & 31;
        const u32x4 w = *(const LAS u32x4*)(buf + n * 64 + ((4 * q) ^ (sw & 28)));
        unsigned a0 = w.x, a1 = w.y, a2 = w.z, a3 = w.w;
        if (sw & 1) { unsigned t = a0; a0 = a1; a1 = t; t = a2; a2 = a3; a3 = t; }
        if (sw & 2) { unsigned t = a0; a0 = a2; a2 = t; t = a1; a1 = a3; a3 = t; }
        u32x4 o; o.x = a0; o.y = a1; o.z = a2; o.w = a3;
        *(u32x4*)(T.dst + (size_t)n * T.ldk + q * 8) = o; }
}

__device__ __forceinline__ void phase_p0(Frame& F) {
    int it = F.bid;
    for (; it < 256; it += F.G) { if (it < 192) p0_modvec_item(F, it); else p0_s5tab_item(F, it - 192); }
    LAS unsigned* buf0 = (LAS unsigned*)F.lds; LAS unsigned* buf1 = (LAS unsigned*)(F.lds + 32768);
    TrItem T{}, Tn{}; f32x4 v[8];
    int ti = it - 256, par = 0;
    if (ti < N_TR_ITEMS) { tr_decode(F, ti, T); tr_load(F, T, v); }
    while (ti < N_TR_ITEMS) {
        LAS unsigned* buf = par ? buf1 : buf0;
        tr_put(F, buf, v);
        const int tn = ti + F.G;
        if (tn < N_TR_ITEMS) { tr_decode(F, tn, Tn); tr_load(F, Tn, v); }
        __syncthreads();
        tr_get(F, buf, T);
        T = Tn; ti = tn; par ^= 1;
    }
    __syncthreads();
}
constexpr int U_STRIDE = 528;
__device__ __forceinline__ void cmul_add(float& xr, float& xi, float ar, float ai, float br, float bi) {
    const float nr = ar * xr - ai * xi + br, ni = ar * xi + ai * xr + bi; xr = nr; xi = ni;
}
__device__ __forceinline__ void phase_s5(Frame& F) {
    const Args& a = *F.a;
    const float* modv0 = (const float*)(F.ws + WS_MODV);
    for (int u = F.bid; u < 256; u += F.G) {
        const int g = 8 * (u & 7) + ((u >> 3) & 7), b = u >> 6;
        {
            const int q4 = F.tid & 3, tl = F.tid >> 2, ch = g * 16 + q4 * 4;
            const f32x4 shl = *(const f32x4*)(modv0 + (size_t)b * 6 * D + ch), scl = *(const f32x4*)(modv0 + (size_t)b * 6 * D + D + ch);
            const f32x4 shc = *(const f32x4*)(modv0 + (size_t)4 * 6 * D + ch), scc = *(const f32x4*)(modv0 + (size_t)4 * 6 * D + D + ch);
            const float* xb = a.in[I_X] + (size_t)b * SEQ * D + ch; const float* cb = a.in[I_CTX] + (size_t)b * CTXL * D + ch;
#pragma unroll 1
            for (int p0 = 0; p0 < 32; p0 += 8) { f32x4 v[8];
#pragma unroll
                for (int pp = 0; pp < 8; ++pp) v[pp] = *(const f32x4*)(xb + (size_t)((p0 + pp) * 128 + tl) * D);
#pragma unroll
                for (int pp = 0; pp < 8; ++pp) { const int e = (p0 + pp) * 128 + tl; f32x4 h;
#pragma unroll
                    for (int j = 0; j < 4; ++j) h[j] = v[pp][j] * (1.f + scl[j]) + shl[j];
                    u32x2 w; w.x = cvt_pk_bf16(h[0], h[1]); w.y = cvt_pk_bf16(h[2], h[3]);
                    *(LAS u32x2*)(F.lds + (e >> 4) * U_STRIDE + (e & 15) * 32 + q4 * 8) = w; }
            }
            { f32x4 v[2];
#pragma unroll
                for (int pp = 0; pp < 2; ++pp) v[pp] = *(const f32x4*)(cb + (size_t)(pp * 128 + tl) * D);
#pragma unroll
                for (int pp = 0; pp < 2; ++pp) { const int e = SEQ + pp * 128 + tl; f32x4 h;
#pragma unroll
                    for (int j = 0; j < 4; ++j) h[j] = v[pp][j] * (1.f + scc[j]) + shc[j];
                    u32x2 w; w.x = cvt_pk_bf16(h[0], h[1]); w.y = cvt_pk_bf16(h[2], h[3]);
                    *(LAS u32x2*)(F.lds + (e >> 4) * U_STRIDE + (e & 15) * 32 + q4 * 8) = w; }
            }
        }
        __syncthreads();
        const int w = F.wave, lane = F.lane, fr = lane & 15, fq = lane >> 4;
        bf16* HT = (bf16*)(F.ws + WS_HT) + (size_t)u * NCHL * 256;
        {
            const int dir = w >> 2;
            const bf16* WIN = (const bf16*)(F.ws + WS_WIN) + (size_t)g * 256 * 256 + (size_t)(w * 32 + fr) * 256 + fq * 8;
            bf16x8 wre[8], wim[8];
#pragma unroll
            for (int kk = 0; kk < 8; ++kk) { wre[kk] = *(const bf16x8*)(WIN + kk * 32); wim[kk] = *(const bf16x8*)(WIN + 16 * 256 + kk * 32); }
            float Ar, Ai;
            { const int idx = (dir * S5G + g) * S5P + (w & 3) * 16 + fr; const float lr = a.in[I_LAMRE][idx], li = a.in[I_LAMIM][idx], dt = expf(a.in[I_LOGDT][dir * S5G + g]);
              const float mag = expf(lr * dt * 16.f), ang = li * dt * 16.f; Ar = mag * cosf(ang); Ai = mag * sinf(ang); }
            const float A2r = Ar * Ar - Ai * Ai, A2i = 2.f * Ar * Ai, A4r = A2r * A2r - A2i * A2i, A4i = 2.f * A2r * A2i;
            float Hr = 0.f, Hi = 0.f;
#pragma unroll 1
            for (int mb = 0; mb < 17; ++mb) {
                const int blk = mb == 0 ? 16 : (dir == 0 ? mb - 1 : 16 - mb);
                const LAS unsigned char* up = F.lds + (blk * 16 + fr) * U_STRIDE + fq * 16;
                f32x4 sre = {0.f, 0.f, 0.f, 0.f}, sim = {0.f, 0.f, 0.f, 0.f};
#pragma unroll
                for (int kk = 0; kk < 8; ++kk) { const bf16x8 ua = *(const LAS bf16x8*)(up + kk * 64);
                    sre = __builtin_amdgcn_mfma_f32_16x16x32_bf16(ua, wre[kk], sre, 0, 0, 0); sim = __builtin_amdgcn_mfma_f32_16x16x32_bf16(ua, wim[kk], sim, 0, 0, 0); }
                float Lr, Li;
                if (dir == 0) { Lr = sre[0]; Li = sim[0]; cmul_add(Lr, Li, Ar, Ai, sre[1], sim[1]); cmul_add(Lr, Li, Ar, Ai, sre[2], sim[2]); cmul_add(Lr, Li, Ar, Ai, sre[3], sim[3]); }
                else          { Lr = sre[3]; Li = sim[3]; cmul_add(Lr, Li, Ar, Ai, sre[2], sim[2]); cmul_add(Lr, Li, Ar, Ai, sre[1], sim[1]); cmul_add(Lr, Li, Ar, Ai, sre[0], sim[0]); }
                float Xr[4], Xi[4];
#pragma unroll
                for (int q = 0; q < 4; ++q) { Xr[q] = __shfl(Lr, q * 16 + fr); Xi[q] = __shfl(Li, q * 16 + fr); }
                float Zr, Zi;
                if (dir == 0) { float cr = Hr, ci = Hi; Zr = cr; Zi = ci;
#pragma unroll
                    for (int q = 0; q < 4; ++q) { cmul_add(cr, ci, A4r, A4i, Xr[q], Xi[q]); if (fq == q + 1) { Zr = cr; Zi = ci; } }
                    Hr = cr; Hi = ci; }
                else { float cr = Hr, ci = Hi; Zr = cr; Zi = ci;
#pragma unroll
                    for (int q = 3; q >= 0; --q) { cmul_add(cr, ci, A4r, A4i, Xr[q], Xi[q]); if (fq == q - 1) { Zr = cr; Zi = ci; } }
                    Hr = cr; Hi = ci; }
                if (mb != 0) {
                    float hr[4], hi[4];
                    if (dir == 0) { hr[0] = Zr; hi[0] = Zi;
#pragma unroll
                        for (int r = 1; r < 4; ++r) { hr[r] = hr[r - 1]; hi[r] = hi[r - 1]; cmul_add(hr[r], hi[r], Ar, Ai, sre[r - 1], sim[r - 1]); } }
                    else { hr[3] = Zr; hi[3] = Zi;
#pragma unroll
                        for (int r = 2; r >= 0; --r) { hr[r] = hr[r + 1]; hi[r] = hi[r + 1]; cmul_add(hr[r], hi[r], Ar, Ai, sre[r + 1], sim[r + 1]); } }
#pragma unroll
                    for (int r = 0; r < 4; ++r) *(unsigned*)(HT + (size_t)(blk * 16 + 4 * fq + r) * 256 + w * 32 + 2 * fr) = cvt_pk_bf16(hr[r], hi[r]);
                }
            }
        }
        __syncthreads();
        {
            const bf16* WY = (const bf16*)(F.ws + WS_WY) + (size_t)g * 256 * 512 + (size_t)(w * 32 + fr) * 512 + fq * 8;
            bf16x8 wy0[16], wy1[16];
#pragma unroll
            for (int kk = 0; kk < 16; ++kk) { wy0[kk] = *(const bf16x8*)(WY + kk * 32); wy1[kk] = *(const bf16x8*)(WY + 16 * 512 + kk * 32); }
            bf16* Y = (bf16*)(F.ws + WS_Y) + ((size_t)g * NTOK + (size_t)b * SEQ) * 16;
#pragma unroll 1
            for (int mb = 0; mb < 16; ++mb) {
                bf16x8 hcur[8];
#pragma unroll
                for (int kk = 0; kk < 8; ++kk) hcur[kk] = *(const bf16x8*)(HT + (size_t)(mb * 16 + fr) * 256 + kk * 32 + fq * 8);
                const LAS unsigned char* up = F.lds + (mb * 16 + fr) * U_STRIDE + fq * 16;
                f32x4 y0 = {0.f, 0.f, 0.f, 0.f}, y1 = {0.f, 0.f, 0.f, 0.f};
#pragma unroll
                for (int kk = 0; kk < 8; ++kk) { const bf16x8 ua = *(const LAS bf16x8*)(up + kk * 64);
                    y0 = __builtin_amdgcn_mfma_f32_16x16x32_bf16(wy0[kk], ua, y0, 0, 0, 0); y1 = __builtin_amdgcn_mfma_f32_16x16x32_bf16(wy1[kk], ua, y1, 0, 0, 0); }
#pragma unroll
                for (int kk = 0; kk < 8; ++kk) { y0 = __builtin_amdgcn_mfma_f32_16x16x32_bf16(wy0[8 + kk], hcur[kk], y0, 0, 0, 0); y1 = __builtin_amdgcn_mfma_f32_16x16x32_bf16(wy1[8 + kk], hcur[kk], y1, 0, 0, 0); }
                const size_t tok = (size_t)(mb * 16 + fr) * 16 + 2 * w;
                u32x2 o0, o1;
                o0.x = cvt_pk_bf16(gelu_tanh_f(y0[0]), gelu_tanh_f(y0[1])); o0.y = cvt_pk_bf16(gelu_tanh_f(y0[2]), gelu_tanh_f(y0[3]));
                o1.x = cvt_pk_bf16(gelu_tanh_f(y1[0]), gelu_tanh_f(y1[1])); o1.y = cvt_pk_bf16(gelu_tanh_f(y1[2]), gelu_tanh_f(y1[3]));
                *(u32x2*)(Y + tok * 16 + 4 * fq) = o0; *(u32x2*)(Y + (tok + 1) * 16 + 4 * fq) = o1;
            }
        }
        __syncthreads();
    }
}
struct Row16 { f32x4 v[4]; };
__device__ __forceinline__ void ln_row(Row16& r, const float* lng, const float* lnb, int lane) {
    float s = 0.f;
#pragma unroll
    for (int j = 0; j < 4; ++j) s += (r.v[j][0] + r.v[j][1]) + (r.v[j][2] + r.v[j][3]);
    const float mean = wave_sum(s) * (1.f / D); float q = 0.f;
#pragma unroll
    for (int j = 0; j < 4; ++j) { r.v[j] = r.v[j] - mean; q += (r.v[j][0] * r.v[j][0] + r.v[j][1] * r.v[j][1]) + (r.v[j][2] * r.v[j][2] + r.v[j][3] * r.v[j][3]); }
    const float rstd = 1.f / sqrtf(wave_sum(q) * (1.f / D) + LN_EPS);
#pragma unroll
    for (int j = 0; j < 4; ++j) { const f32x4 gg = *(const f32x4*)(lng + 256 * j + 4 * lane), bb = *(const f32x4*)(lnb + 256 * j + 4 * lane); r.v[j] = r.v[j] * rstd * gg + bb; }
}

template <int LAYER>
__device__ __forceinline__ void phase_lnrouter(Frame& F) {
    const Args& a = *F.a;
    const float* modv = (const float*)(F.ws + WS_MODV) + (size_t)LAYER * 5 * 6 * D;
    const float* lng = a.in[I_LNG] + (size_t)(LAYER * 2) * D; const float* lnb = a.in[I_LNB] + (size_t)(LAYER * 2) * D;
    LAS float* rwt = (LAS float*)F.lds;
    LAS int* cnt16 = (LAS int*)(F.lds + 65536);
    for (int i = F.tid; i < D * NE; i += NTHR) rwt[(i & 15) * D + (i >> 4)] = a.in[I_RW][i];
    if (F.tid < 16) cnt16[F.tid] = 0;
    __syncthreads();
    const int lane = F.lane;
    float rb[NE];
#pragma unroll
    for (int e = 0; e < NE; ++e) rb[e] = a.in[I_RB][e];
    float* X1 = (float*)(F.ws + WS_X1); bf16* H2 = (bf16*)(F.ws + WS_H2);
    int* eidx = (int*)(F.ws + WS_EIDX); float* ew = (float*)(F.ws + WS_EW);
    for (int wg = F.bid; wg < NTOK / 64; wg += F.G) {
#pragma unroll 1
        for (int rr = 0; rr < 8; ++rr) {
            const int row = wg * 64 + F.wave * 8 + rr, b = row / SEQ;
            const float* ml = modv + (size_t)b * 6 * D;
            Row16 r;
            if (LAYER == 0) {
                const float* R1 = (const float*)(F.ws + WS_U) + (size_t)row * D;
#pragma unroll
                for (int j = 0; j < 4; ++j) r.v[j] = *(const f32x4*)(R1 + 256 * j + 4 * lane);
            } else {
                const bf16* Z = (const bf16*)(F.ws + WS_Z); const bf16* HS = (const bf16*)(F.ws + WS_HS);
                const float* X2 = a.out + (size_t)row * D;
                const int t = row % SEQ, gr = t >> 6, gx = t & 63;
#pragma unroll
                for (int j = 0; j < 4; ++j) { const int k = 2 << j, ch = 256 * j + 4 * lane;
                    const int rlo = max(gr - k / 2, 0), rhi = min(gr + k - k / 2, 64), clo = max(gx - k / 2, 0), chi = min(gx + k - k / 2, 64);
                    f32x4 vs = {0.f, 0.f, 0.f, 0.f};
                    for (int r2 = rlo; r2 < rhi; ++r2) { const u32x2 hw = *(const u32x2*)(HS + ((size_t)(row - t) + r2 * 64 + gx) * D + ch);
                        vs[0] += bf_lo(hw.x); vs[1] += bf_hi(hw.x); vs[2] += bf_lo(hw.y); vs[3] += bf_hi(hw.y); }
                    const float inv = 1.f / (float)((rhi - rlo) * (chi - clo));
                    const u32x2 zw = *(const u32x2*)(Z + (size_t)row * D + ch);
                    const f32x4 z = {bf_lo(zw.x), bf_hi(zw.x), bf_lo(zw.y), bf_hi(zw.y)};
                    const f32x4 sc = *(const f32x4*)(a.in[I_POOLS] + ch), g1 = *(const f32x4*)(ml + 2 * D + ch), xv = *(const f32x4*)(X2 + ch);
                    r.v[j] = DN_ALPHA * xv + g1 * ((vs * inv - z) * sc); }
            }
            ln_row(r, lng, lnb, lane);
            float* x1p = X1 + (size_t)row * D; bf16* h2p = H2 + (size_t)row * D;
            float lg[NE];
#pragma unroll
            for (int e = 0; e < NE; ++e) lg[e] = 0.f;
#pragma unroll
            for (int j = 0; j < 4; ++j) { const int ch = 256 * j + 4 * lane;
                *(f32x4*)(x1p + ch) = r.v[j];
                const f32x4 sc2 = *(const f32x4*)(ml + 4 * D + ch), sh2 = *(const f32x4*)(ml + 3 * D + ch);
                const f32x4 h = r.v[j] * (1.f + sc2) + sh2;
                u32x2 hw; hw.x = cvt_pk_bf16(h[0], h[1]); hw.y = cvt_pk_bf16(h[2], h[3]); *(u32x2*)(h2p + ch) = hw;
#pragma unroll
                for (int e = 0; e < NE; ++e) { const f32x4 wv = *(const LAS f32x4*)(rwt + e * D + ch); lg[e] += (h[0] * wv[0] + h[1] * wv[1]) + (h[2] * wv[2] + h[3] * wv[3]); } }
#pragma unroll
            for (int e = 0; e < NE; ++e) lg[e] = wave_sum(lg[e]) + rb[e];
            float mx = lg[0];
#pragma unroll
            for (int e = 1; e < NE; ++e) mx = fmaxf(mx, lg[e]);
            float sc[NE], sum = 0.f;
#pragma unroll
            for (int e = 0; e < NE; ++e) { sc[e] = expf(lg[e] - mx); sum += sc[e]; }
            const float isum = 1.f / sum;
#pragma unroll
            for (int e = 0; e < NE; ++e) sc[e] *= isum;
            int best = 0; float bestv = -1.f; int bi1 = 0, bi2 = 0; float bv1 = 0.f, bv2 = 0.f;
#pragma unroll
            for (int gq = 0; gq < NGRP; ++gq) { float m1 = -1.f, m2 = -1.f; int i1 = 0, i2 = 0;
#pragma unroll
                for (int j = 0; j < EPG; ++j) { const float v = sc[gq * EPG + j]; if (v > m1) { m2 = m1; i2 = i1; m1 = v; i1 = j; } else if (v > m2) { m2 = v; i2 = j; } }
                const float gs = m1 + m2; if (gs > bestv) { bestv = gs; best = gq; bi1 = i1; bi2 = i2; bv1 = m1; bv2 = m2; } }
            if (lane == 0) { const float ws_ = 1.f / (bv1 + bv2); const int e1 = best * EPG + bi1, e2 = best * EPG + bi2;
                eidx[row * 2] = e1; eidx[row * 2 + 1] = e2; ew[row * 2] = bv1 * ws_; ew[row * 2 + 1] = bv2 * ws_;
                __hip_atomic_fetch_add(&cnt16[e1], 1, __ATOMIC_RELAXED, __HIP_MEMORY_SCOPE_WORKGROUP); __hip_atomic_fetch_add(&cnt16[e2], 1, __ATOMIC_RELAXED, __HIP_MEMORY_SCOPE_WORKGROUP); }
        }
        __syncthreads();
        if (F.tid < 16) { ((int*)(F.ws + WS_CNT))[wg * 16 + F.tid] = cnt16[F.tid]; cnt16[F.tid] = 0; }
        __syncthreads();
    }
}

__device__ __forceinline__ void phase_sort(Frame& F) {
    const int* cnt = (const int*)(F.ws + WS_CNT);
    const int* eidx = (const int*)(F.ws + WS_EIDX);
    int* slot_tok = (int*)(F.ws + WS_SLOTTOK); int* tok_slot = (int*)(F.ws + WS_TOKSLOT); int* tile_e = (int*)(F.ws + WS_TILEE);
    LAS int* ptot = (LAS int*)F.lds;
    LAS int* poff = ptot + 512;
    LAS int* tot = poff + 512;
    LAS int* base = tot + 16;
    for (int c = F.bid; c < NTOK / 64; c += F.G) {
        { const int e = F.tid & 15, part = F.tid >> 4; int st = 0, so = 0;
          for (int q = 0; q < 8; ++q) { const int wg = part * 8 + q; const int v = cnt[wg * 16 + e]; st += v; if (wg < c) so += v; }
          ptot[part * 16 + e] = st; poff[part * 16 + e] = so; }
        __syncthreads();
        if (F.tid < 16) { int st = 0, so = 0; for (int p = 0; p < 32; ++p) { st += ptot[p * 16 + F.tid]; so += poff[p * 16 + F.tid]; } tot[F.tid] = st; poff[F.tid] = so; }
        __syncthreads();
        if (F.tid == 0) { int run = 0; for (int e = 0; e < NE; ++e) { base[e] = run; run += (tot[e] + 255) / 256 * 256; } base[NE] = run; }
        __syncthreads();
        if (F.tid < 16) { const int e = F.tid; int s = base[e] + poff[e];
            for (int i = 0; i < 128; ++i) { if (eidx[c * 128 + i] == e) { slot_tok[s] = c * 64 + (i >> 1); tok_slot[c * 128 + i] = s; ++s; } } }
        if (c == 0) {
            if (F.tid < 16) { const int e = F.tid; for (int s = base[e] + tot[e]; s < base[e + 1]; ++s) slot_tok[s] = 0;
                for (int q = base[e] / 256; q < base[e + 1] / 256; ++q) tile_e[q] = e; }
            if (F.tid == 0) tile_e[255] = base[NE] / 256;
        }
        __syncthreads();
    }
}

template <int LAYER>
__device__ __forceinline__ void phase_combine(Frame& F) {
    const Args& a = *F.a;
    const float* modv = (const float*)(F.ws + WS_MODV) + (size_t)LAYER * 5 * 6 * D;
    const float* modn = (const float*)(F.ws + WS_MODV) + (size_t)1 * 5 * 6 * D;
    const float* lng = a.in[I_LNG] + (size_t)(LAYER * 2 + 1) * D; const float* lnb = a.in[I_LNB] + (size_t)(LAYER * 2 + 1) * D;
    const float* X1 = (const float*)(F.ws + WS_X1); const bf16* O = (const bf16*)(F.ws + WS_U);
    const int* tok_slot = (const int*)(F.ws + WS_TOKSLOT); const float* ew = (const float*)(F.ws + WS_EW);
    bf16* HP = (bf16*)(F.ws + WS_HP);
    const int lane = F.lane;
    for (int wg = F.bid; wg < NTOK / 64; wg += F.G) {
#pragma unroll 1
        for (int rr = 0; rr < 8; ++rr) {
            const int row = wg * 64 + F.wave * 8 + rr, b = row / SEQ;
            const float* ml = modv + (size_t)b * 6 * D;
            const int s0 = tok_slot[row * 2], s1 = tok_slot[row * 2 + 1]; const float w0 = ew[row * 2], w1 = ew[row * 2 + 1];
            Row16 r;
#pragma unroll
            for (int j = 0; j < 4; ++j) { const int ch = 256 * j + 4 * lane;
                const u32x2 p0 = *(const u32x2*)(O + (size_t)s0 * D + ch), p1 = *(const u32x2*)(O + (size_t)s1 * D + ch);
                const f32x4 o0 = {bf_lo(p0.x), bf_hi(p0.x), bf_lo(p0.y), bf_hi(p0.y)}, o1 = {bf_lo(p1.x), bf_hi(p1.x), bf_lo(p1.y), bf_hi(p1.y)};
                const f32x4 xv = *(const f32x4*)(X1 + (size_t)row * D + ch), g2 = *(const f32x4*)(ml + 5 * D + ch);
                r.v[j] = DN_ALPHA * xv + g2 * (o0 * w0 + o1 * w1); }
            ln_row(r, lng, lnb, lane);
#pragma unroll
            for (int j = 0; j < 4; ++j) { const int ch = 256 * j + 4 * lane;
                *(f32x4*)(a.out + (size_t)row * D + ch) = r.v[j];
                if (LAYER == 0) { const float* mn = modn + (size_t)b * 6 * D; const f32x4 sc = *(const f32x4*)(mn + D + ch), sh = *(const f32x4*)(mn + ch);
                    const f32x4 h = r.v[j] * (1.f + sc) + sh; u32x2 hw; hw.x = cvt_pk_bf16(h[0], h[1]); hw.y = cvt_pk_bf16(h[2], h[3]); *(u32x2*)(HP + (size_t)row * D + ch) = hw; } }
        }
    }
}

__device__ __forceinline__ void phase_hsum(Frame& F) {
    const bf16* Z = (const bf16*)(F.ws + WS_Z); bf16* HS = (bf16*)(F.ws + WS_HS);
    for (int it = F.bid * NTHR + F.tid; it < NTOK * 128; it += F.G * NTHR) {
        const int tok = it >> 7, cb = it & 127, ch = cb * 8, k = 2 << (ch >> 8), gx = tok & 63;
        const int clo = max(gx - k / 2, 0), chi = min(gx + k - k / 2, 64);
        float s[8];
#pragma unroll
        for (int i = 0; i < 8; ++i) s[i] = 0.f;
        for (int x2 = clo; x2 < chi; ++x2) { const u32x4 w = *(const u32x4*)(Z + (size_t)(tok - gx + x2) * D + ch);
            s[0] += bf_lo(w.x); s[1] += bf_hi(w.x); s[2] += bf_lo(w.y); s[3] += bf_hi(w.y); s[4] += bf_lo(w.z); s[5] += bf_hi(w.z); s[6] += bf_lo(w.w); s[7] += bf_hi(w.w); }
        u32x4 o; o.x = cvt_pk_bf16(s[0], s[1]); o.y = cvt_pk_bf16(s[2], s[3]); o.z = cvt_pk_bf16(s[4], s[5]); o.w = cvt_pk_bf16(s[6], s[7]);
        *(u32x4*)(HS + (size_t)tok * D + ch) = o;
    }
}

constexpr int NPH = 15;
__global__ void __launch_bounds__(NTHR, 2) mk_fwd(Args args) {
    extern __shared__ __attribute__((aligned(16))) unsigned char lds_raw[];
    Frame F;
    F.lds = (LAS unsigned char*)lds_raw; F.tid = threadIdx.x; F.lane = F.tid & 63; F.wave = __builtin_amdgcn_readfirstlane(F.tid >> 6);
    F.bid = blockIdx.x; F.G = gridDim.x; F.a = &args; F.ws = args.ws;
    volatile LAS unsigned* MISC = (volatile LAS unsigned*)(F.lds + LDS_MISC);
    if (F.tid < 64) MISC[F.tid] = 0u;
    __syncthreads();
    XcdBarrier bar = xcd_barrier_post((unsigned*)(F.ws + WS_CTL), MISC);
    const int lo = args.ph_lo, hi = args.ph_hi;
#ifndef PH_MASK
#define PH_MASK 0x7fff
#endif
#define IN(k) (((PH_MASK >> (k)) & 1) && lo <= (k) && (k) < hi)
#define SEAM(k) do { if (IN(k) && IN((k) + 1)) xcd_barrier(bar); } while (0)
    if (IN(0)) phase_p0(F);
    SEAM(0);
    if (IN(1)) phase_s5(F);
    SEAM(1);
    if (IN(2)) {
        pg8::AGroupMajor AL{(const char*)(F.ws + WS_Y)}; pg8::StaticOrder S; S.init(NTOK, 2048, F.G, F.bid);
        pg8::EpiGlu E{args.in[I_X], (const float*)(F.ws + WS_MODV), (float*)(F.ws + WS_U)};
        pg8::gemm_phase(F.lds, AL, (const bf16*)(F.ws + WS_WVG), 1024, S, E);
    }
    SEAM(2);
    if (IN(3)) phase_lnrouter<0>(F);
    SEAM(3);
    if (IN(4)) phase_sort(F);
    SEAM(4);
    if (IN(5)) {
        const int* tile_e = (const int*)(F.ws + WS_TILEE);
        pg8::AGather AL{(const char*)(F.ws + WS_H2), D, (const int*)(F.ws + WS_SLOTTOK)}; pg8::MoeOrder S{tile_e, tile_e[255], 8, F.G, F.bid};
        pg8::EpiSwiglu E{(bf16*)(F.ws + WS_ACT)};
        pg8::gemm_phase(F.lds, AL, (const bf16*)(F.ws + WS_WGU), 1024, S, E);
    }
    SEAM(5);
    if (IN(6)) {
        const int* tile_e = (const int*)(F.ws + WS_TILEE);
        pg8::ARows AL{(const char*)(F.ws + WS_ACT), FF, 0}; pg8::MoeOrder S{tile_e, tile_e[255], 4, F.G, F.bid};
        pg8::EpiBf16 E{(bf16*)(F.ws + WS_U), D};
        pg8::gemm_phase(F.lds, AL, (const bf16*)(F.ws + WS_WD), 1024, S, E);
    }
    SEAM(6);
    if (IN(7)) phase_combine<0>(F);
    SEAM(7);
    if (IN(8)) {
        pg8::ARows AL{(const char*)(F.ws + WS_HP), D, 256}; pg8::StaticOrder S; S.init(NTOK, 1024, F.G, F.bid);
        pg8::EpiBf16 E{(bf16*)(F.ws + WS_Z), D};
        pg8::gemm_phase(F.lds, AL, (const bf16*)(F.ws + WS_WP), 256, S, E);
    }
    SEAM(8);
    if (IN(9)) phase_hsum(F);
    SEAM(9);
    if (IN(10)) phase_lnrouter<1>(F);
    SEAM(10);
    if (IN(11)) phase_sort(F);
    SEAM(11);
    if (IN(12)) {
        const int* tile_e = (const int*)(F.ws + WS_TILEE);
        pg8::AGather AL{(const char*)(F.ws + WS_H2), D, (const int*)(F.ws + WS_SLOTTOK)}; pg8::MoeOrder S{tile_e, tile_e[255], 8, F.G, F.bid};
        pg8::EpiSwiglu E{(bf16*)(F.ws + WS_ACT)};
        pg8::gemm_phase(F.lds, AL, (const bf16*)(F.ws + WS_WGU) + (size_t)16 * 2048 * 1024, 1024, S, E);
    }
    SEAM(12);
    if (IN(13)) {
        const int* tile_e = (const int*)(F.ws + WS_TILEE);
        pg8::ARows AL{(const char*)(F.ws + WS_ACT), FF, 0}; pg8::MoeOrder S{tile_e, tile_e[255], 4, F.G, F.bid};
        pg8::EpiBf16 E{(bf16*)(F.ws + WS_U), D};
        pg8::gemm_phase(F.lds, AL, (const bf16*)(F.ws + WS_WD) + (size_t)16 * 1024 * 1024, 1024, S, E);
    }
    SEAM(13);
    if (IN(14)) phase_combine<1>(F);
#undef IN
#undef SEAM
}

extern "C" void kernel_launch(void* const* d_in, const int* in_sizes, int n_in, void* d_out, int out_size, void* d_ws, size_t ws_size, hipStream_t stream) {
    static int ready = 0;
    if (ready == 0) {
        if (n_in != 25 || out_size != NTOK * D || ws_size < WS_END) { fprintf(stderr, "kernel_launch: unexpected problem shape (n_in %d, out %d, ws %zu)\n", n_in, out_size, ws_size); ready = -1; return; }
        if (hipFuncSetAttribute((const void*)mk_fwd, hipFuncAttributeMaxDynamicSharedMemorySize, LDS_BYTES) != hipSuccess) { fprintf(stderr, "kernel_launch: hipFuncSetAttribute failed\n"); ready = -1; return; }
        int per_cu = 0; (void)hipOccupancyMaxActiveBlocksPerMultiprocessor(&per_cu, (const void*)mk_fwd, NTHR, LDS_BYTES); (void)hipGetLastError();
        if (per_cu < 1) fprintf(stderr, "kernel_launch: occupancy query says %d workgroups per CU\n", per_cu);
        ready = 1;
    }
    if (ready < 0) return;
    (void)in_sizes;
    (void)hipMemsetAsync((char*)d_ws + WS_CTL, 0, CTL_ZERO_BYTES, stream);
    Args a{};
    for (int i = 0; i < 25; ++i) a.in[i] = (const float*)d_in[i];
    a.out = (float*)d_out; a.ws = (unsigned char*)d_ws;
#if MK_PER_PHASE
    for (int p = 0; p < NPH; ++p) { a.ph_lo = p; a.ph_hi = p + 1; hipLaunchKernelGGL(mk_fwd, dim3(NWG), dim3(NTHR), LDS_BYTES, stream, a); }
#else
    a.ph_lo = 0; a.ph_hi = NPH; hipLaunchKernelGGL(mk_fwd, dim3(NWG), dim3(NTHR), LDS_BYTES, stream, a);
#endif
}
```
